# Optimizing an MI355X kernel written in HIP

```python
import math
import jax, jax.numpy as jnp
from jax import lax
import numpy as np

D_MODEL = 2048
BATCH = 2
SEQ = 8192
DEPTH = 4

N_A_LAYERS = DEPTH // 2
N_B_LAYERS = DEPTH - N_A_LAYERS
HEAD_DIM = 128
A_HEADS = D_MODEL // (2 * HEAD_DIM)
A_SUBHEADS = 2 * A_HEADS
A_V_DIM = 2 * HEAD_DIM
B_HEADS = D_MODEL // HEAD_DIM
D_FF = 5504
NUM_BUCKETS = 32
MAX_DISTANCE = 128
Q_BLOCK = 128
EPS = 1e-6
BIAS_INIT = 0.5

kernel_name = "yoco_diffattn_stickbreaking_macaron"


def _rms_norm(x, g):
    xf = x.astype(jnp.float32)
    y = xf * lax.rsqrt(jnp.mean(xf * xf, axis=-1, keepdims=True) + EPS)
    return (y * g.astype(jnp.float32)).astype(x.dtype)


def _swiglu(x, wi, wo):
    gate, up = jnp.split(x @ wi, 2, axis=-1)
    return (jax.nn.silu(gate) * up) @ wo


def _t5_bucket(qpos, kpos):
    n = jnp.maximum(qpos[:, None] - kpos[None, :], 0)
    max_exact = NUM_BUCKETS // 2
    nf = jnp.maximum(n, max_exact).astype(jnp.float32)
    large = max_exact + (jnp.log(nf / max_exact) / math.log(MAX_DISTANCE / max_exact)
                         * (NUM_BUCKETS - max_exact)).astype(jnp.int32)
    large = jnp.minimum(large, NUM_BUCKETS - 1)
    return jnp.where(n < max_exact, n, large)


def _to_blocks(t):
    return jnp.swapaxes(t.reshape(t.shape[0], t.shape[1] // Q_BLOCK, Q_BLOCK, *t.shape[2:]), 0, 1)


def _from_blocks(t):
    t = jnp.swapaxes(t, 0, 1)
    return t.reshape(t.shape[0], t.shape[1] * t.shape[2], *t.shape[3:])


def _diff_attention(h, wqkv, q_g, k_g, lam_vecs, subln_g, wo, rel_bias, lambda_init):
    B, S, _ = h.shape
    q, k, v = jnp.split(h @ wqkv, 3, axis=-1)
    q = _rms_norm(q.reshape(B, S, A_SUBHEADS, HEAD_DIM), q_g)
    k = _rms_norm(k.reshape(B, S, A_SUBHEADS, HEAD_DIM), k_g)
    v = v.reshape(B, S, A_HEADS, A_V_DIM)
    lf = lam_vecs.astype(jnp.float32)
    lam = jnp.exp(jnp.sum(lf[0] * lf[1])) - jnp.exp(jnp.sum(lf[2] * lf[3])) + lambda_init
    kpos = jnp.arange(S)
    scale = HEAD_DIM ** -0.5

    def block(args):
        qb, start = args
        qpos = start + jnp.arange(Q_BLOCK)
        logits = jnp.einsum('bqhd,bkhd->bhqk', qb, k).astype(jnp.float32) * scale
        bias = jnp.moveaxis(rel_bias[_t5_bucket(qpos, kpos)], -1, 0).astype(jnp.float32)
        causal = kpos[None, :] <= qpos[:, None]
        logits = jnp.where(causal, logits + bias[None], -jnp.inf)
        p = jax.nn.softmax(logits, axis=-1).reshape(B, A_HEADS, 2, Q_BLOCK, S)
        attn = p[:, :, 0] - lam * p[:, :, 1]
        return jnp.einsum('bhqk,bkhe->bqhe', attn.astype(v.dtype), v)

    starts = jnp.arange(S // Q_BLOCK) * Q_BLOCK
    o = _from_blocks(lax.map(block, (_to_blocks(q), starts)))
    o = _rms_norm(o, subln_g) * (1.0 - lambda_init)
    return o.reshape(B, S, D_MODEL) @ wo


def _stick_breaking(h, wq, k, v, wo):
    B, S, _ = h.shape
    q = (h @ wq).reshape(B, S, B_HEADS, HEAD_DIM)
    kpos = jnp.arange(S)
    scale = HEAD_DIM ** -0.5

    def block(args):
        qb, start = args
        qpos = start + jnp.arange(Q_BLOCK)
        z = jnp.einsum('bqhd,bkhd->bhqk', qb, k).astype(jnp.float32) * scale
        strict = kpos[None, :] < qpos[:, None]
        log_keep = jnp.where(strict, jax.nn.log_sigmoid(-z), 0.0)
        key_axis = log_keep.ndim - 1
        log_w = jax.nn.log_sigmoid(z) + lax.cumsum(log_keep, axis=key_axis, reverse=True) - log_keep
        w = jnp.where(strict, jnp.exp(log_w), 0.0)
        return jnp.einsum('bhqk,bkhd->bqhd', w.astype(v.dtype), v)

    starts = jnp.arange(S // Q_BLOCK) * Q_BLOCK
    o = _from_blocks(lax.map(block, (_to_blocks(q), starts)))
    return o.reshape(B, S, D_MODEL) @ wo


def setup_inputs(seed: int = 0) -> dict:
    key = jax.random.key(seed)
    ks = jax.random.split(key, 20)
    f32 = jnp.float32

    def w(k, shape, fan_in):
        return jax.random.normal(k, shape, f32) * fan_in ** -0.5

    def gain(k, shape):
        return 1.0 + 0.02 * jax.random.normal(k, shape, f32)

    return {
        "x": jax.random.normal(ks[0], (BATCH, SEQ, D_MODEL), f32),
        "ffn_pre_norm": gain(ks[1], (DEPTH, D_MODEL)),
        "ffn_pre_wi": w(ks[2], (DEPTH, D_MODEL, 2 * D_FF), D_MODEL),
        "ffn_pre_wo": w(ks[3], (DEPTH, D_FF, D_MODEL), D_FF),
        "mix_norm": gain(ks[4], (DEPTH, D_MODEL)),
        "ffn_post_norm": gain(ks[5], (DEPTH, D_MODEL)),
        "ffn_post_wi": w(ks[6], (DEPTH, D_MODEL, 2 * D_FF), D_MODEL),
        "ffn_post_wo": w(ks[7], (DEPTH, D_FF, D_MODEL), D_FF),
        "rel_bias": BIAS_INIT * jax.random.normal(ks[8], (NUM_BUCKETS, A_SUBHEADS), f32),
        "a_wqkv": w(ks[9], (N_A_LAYERS, D_MODEL, 3 * D_MODEL), D_MODEL),
        "a_q_norm": gain(ks[10], (N_A_LAYERS, HEAD_DIM)),
        "a_k_norm": gain(ks[11], (N_A_LAYERS, HEAD_DIM)),
        "a_lambda": 0.1 * jax.random.normal(ks[12], (N_A_LAYERS, 4, HEAD_DIM), f32),
        "a_subln": gain(ks[13], (N_A_LAYERS, A_V_DIM)),
        "a_wo": w(ks[14], (N_A_LAYERS, D_MODEL, D_MODEL), D_MODEL),
        "kv_norm": gain(ks[15], (D_MODEL,)),
        "b_wkv": w(ks[16], (D_MODEL, 2 * D_MODEL), D_MODEL),
        "b_wq": w(ks[17], (N_B_LAYERS, D_MODEL, D_MODEL), D_MODEL),
        "b_wo": w(ks[18], (N_B_LAYERS, D_MODEL, D_MODEL), D_MODEL),
    }


def reference(x, ffn_pre_norm, ffn_pre_wi, ffn_pre_wo, mix_norm, ffn_post_norm, ffn_post_wi,
              ffn_post_wo, rel_bias, a_wqkv, a_q_norm, a_k_norm, a_lambda, a_subln, a_wo,
              kv_norm, b_wkv, b_wq, b_wo):
    B, S, _ = x.shape
    k_sh = None
    v_sh = None
    for l in range(DEPTH):
        if l == N_A_LAYERS:
            k_sh, v_sh = jnp.split(_rms_norm(x, kv_norm) @ b_wkv, 2, axis=-1)
            k_sh = k_sh.reshape(B, S, B_HEADS, HEAD_DIM)
            v_sh = v_sh.reshape(B, S, B_HEADS, HEAD_DIM)
        x = x + 0.5 * _swiglu(_rms_norm(x, ffn_pre_norm[l]), ffn_pre_wi[l], ffn_pre_wo[l])
        h = _rms_norm(x, mix_norm[l])
        if l < N_A_LAYERS:
            lambda_init = 0.8 - 0.6 * math.exp(-0.3 * l)
            x = x + _diff_attention(h, a_wqkv[l], a_q_norm[l], a_k_norm[l], a_lambda[l],
                                    a_subln[l], a_wo[l], rel_bias, lambda_init)
        else:
            i = l - N_A_LAYERS
            x = x + _stick_breaking(h, b_wq[i], k_sh, v_sh, b_wo[i])
        x = x + 0.5 * _swiglu(_rms_norm(x, ffn_post_norm[l]), ffn_post_wi[l], ffn_post_wo[l])
    return x
```

```cpp
#include <hip/hip_runtime.h>
#include <cstdio>
#include <cstdint>
namespace pg8 {
#define PG8_LAS __attribute__((address_space(3)))
typedef unsigned short bf16_t;
typedef short bf16x8 __attribute__((ext_vector_type(8)));
typedef float f32x4 __attribute__((ext_vector_type(4)));
typedef unsigned u32x4 __attribute__((ext_vector_type(4)));
constexpr int BM = 256, BK = 64, HALF = 128, HTB = HALF * BK * 2  , STAGE_BYTES = 8 * HTB, NXCD = 8, WGM = 8;

__host__ __device__ __forceinline__ int lds_byte(int r, int c) { const int st = (r >> 4) * 2 + (c >> 5), rr = r & 15, cc = c & 31, ob = rr * 64 + cc * 2; return st * 1024 + (ob ^ (((ob >> 9) & 1) << 5)); }
__host__ __device__ __forceinline__ void stage_rc(int b, int& R, int& C) { const int st = b / 1024, sb = b % 1024, swz = sb ^ (((sb >> 9) & 1) << 5); R = (st >> 1) * 16 + swz / 64; C = (st & 1) * 32 + (swz % 64) / 2; }
__host__ __device__ __forceinline__ int perm32(int rho) { const int n = rho >> 4, i = rho & 15; return 8 * (i >> 2) + 4 * n + (i & 3); }

struct Unit { int pm, pn; };
struct Gemm { const bf16_t* A; const bf16_t* Bt; int M, N, K; };

struct StaticOrder {
    int nM, nN, nwg, G, c;
    __host__ __device__ void init(int M, int N, int G_, int c_) { nM = M / BM; nN = N / BM; nwg = nM * nN; G = G_; c = c_; }
    __host__ __device__ bool next(int i, Unit& u) const {
        const long L = (long)i * G + c; if (L >= nwg) return false;
        int wgid = (int)L; { const int q = nwg / NXCD, r = nwg % NXCD, xcd = wgid % NXCD, off = wgid / NXCD; wgid = (xcd < r ? xcd * (q + 1) : r * (q + 1) + (xcd - r) * q) + off; }
        const int nig = WGM * nN, gid = wgid / nig, fm = gid * WGM, gsz = (nM - fm) < WGM ? (nM - fm) : WGM;
        u.pm = fm + ((wgid % nig) % gsz); u.pn = (wgid % nig) / gsz; return true;
    }
    __device__ __forceinline__ void a_ready(const Unit&) const {}
    __device__ __forceinline__ void done(const Unit&) const {}
};

__device__ __forceinline__ unsigned cvt_pk_bf16(float lo, float hi) { unsigned r; asm volatile("v_cvt_pk_bf16_f32 %0, %1, %2" : "=v"(r) : "v"(lo), "v"(hi)); return r; }
struct EpiBf16 {
    static constexpr bool PERM = true, AFTER_DRAIN = false;
    bf16_t* O; int ldc;
    __device__ __forceinline__ void operator()(const f32x4 (&acc)[2][2][4][2], const Unit& u, int wr, int wc, int fr, int fq) const {
        const int row0 = u.pm * BM + wr * 64 + fr, col0 = u.pn * BM + wc * 32 + 8 * fq;
#pragma unroll
        for (int ai = 0; ai < 2; ++ai)
#pragma unroll
            for (int m = 0; m < 4; ++m) { bf16_t* rowp = O + (size_t)(row0 + ai * HALF + m * 16) * ldc + col0;
#pragma unroll
                for (int bj = 0; bj < 2; ++bj) { const f32x4 v0 = acc[ai][bj][m][0], v1 = acc[ai][bj][m][1];
                    u32x4 w; w.x = cvt_pk_bf16(v0[0], v0[1]); w.y = cvt_pk_bf16(v0[2], v0[3]); w.z = cvt_pk_bf16(v1[0], v1[1]); w.w = cvt_pk_bf16(v1[2], v1[3]);
                    *(u32x4*)(rowp + bj * HALF) = w; } }
    }
};
__device__ __forceinline__ float silu_mul(float g, float u) { return g * u * __builtin_amdgcn_rcpf(1.0f + __expf(-g)); }
struct EpiSwiGLU {
    static constexpr bool PERM = true, AFTER_DRAIN = false;
    bf16_t* O; int ldc;
    __device__ __forceinline__ void operator()(const f32x4 (&acc)[2][2][4][2], const Unit& u, int wr, int wc, int fr, int fq) const {
        const int row0 = u.pm * BM + wr * 64 + fr, col0 = u.pn * HALF + wc * 32 + 8 * fq;
#pragma unroll
        for (int ai = 0; ai < 2; ++ai)
#pragma unroll
            for (int m = 0; m < 4; ++m) { bf16_t* rowp = O + (size_t)(row0 + ai * HALF + m * 16) * ldc + col0;
                const f32x4 g0 = acc[ai][0][m][0], g1 = acc[ai][0][m][1], u0 = acc[ai][1][m][0], u1 = acc[ai][1][m][1];
                u32x4 w; w.x = cvt_pk_bf16(silu_mul(g0[0], u0[0]), silu_mul(g0[1], u0[1])); w.y = cvt_pk_bf16(silu_mul(g0[2], u0[2]), silu_mul(g0[3], u0[3]));
                w.z = cvt_pk_bf16(silu_mul(g1[0], u1[0]), silu_mul(g1[1], u1[1])); w.w = cvt_pk_bf16(silu_mul(g1[2], u1[2]), silu_mul(g1[3], u1[3]));
                *(u32x4*)rowp = w; }
    }
};
struct EpiResid {
    static constexpr bool PERM = false, AFTER_DRAIN = false;
    const float* base; float* out; int ldc; float scale;
    __device__ __forceinline__ void operator()(const f32x4 (&acc)[2][2][4][2], const Unit& u, int wr, int wc, int fr, int fq) const {
        const int row0 = u.pm * BM + wr * 64 + fr, col0 = u.pn * BM + wc * 32 + 4 * fq;
#pragma unroll
        for (int ai = 0; ai < 2; ++ai)
#pragma unroll
            for (int m = 0; m < 4; ++m) { const size_t off = (size_t)(row0 + ai * HALF + m * 16) * ldc + col0;
#pragma unroll
                for (int bj = 0; bj < 2; ++bj)
#pragma unroll
                    for (int n = 0; n < 2; ++n) { const f32x4 b = *(const f32x4*)(base + off + bj * HALF + n * 16); *(f32x4*)(out + off + bj * HALF + n * 16) = b + acc[ai][bj][m][n] * scale; } }
    }
};

template <class Epi, class Sched, bool ALIGN_EPI = false, bool SP2 = false>
__device__ __forceinline__ void gemm_phase(PG8_LAS unsigned char* lds, const Gemm g, const Sched& S, const Epi& E) {
    int tid_ = threadIdx.x; asm volatile("" : "+v"(tid_));
    const int tid = tid_, wid = __builtin_amdgcn_readfirstlane(tid >> 6), lane = tid & 63, wr = wid >> 2, wc = wid & 3, fr = lane & 15, fq = lane >> 4;
    const int K = g.K, nt = K / BK;
    unsigned voffA[2], voffB[2];
#pragma unroll
    for (int i = 0; i < 2; ++i) { int R, C; stage_rc(tid * 16 + i * 8192, R, C); const int Rb = Epi::PERM ? ((R & ~31) + perm32(R & 31)) : R;
        voffA[i] = (unsigned)(R * K + C) * 2u; voffB[i] = (unsigned)(Rb * K + C) * 2u; }
    const size_t kstep = (size_t)(BK * 2);
    const size_t hstep = (size_t)HALF * K * 2;
    const size_t tstep = 2 * hstep;
    const unsigned ldsw = (unsigned)wid * 1024u;
    const int aoff = lds_byte(wr * 64 + fr, fq * 8), boff = lds_byte(wc * 32 + fr, fq * 8);
#define PG8_SA(b, h) (((b) * 2 + (h)) * HTB)
#define PG8_SB(b, h) ((4 + (b) * 2 + (h)) * HTB)
#define PG8_STAGE(bufoff, gbase, voff) do { _Pragma("unroll") for (int _i = 0; _i < 2; ++_i) \
        __builtin_amdgcn_global_load_lds((const unsigned*)((const char*)(gbase) + (voff)[_i]), (PG8_LAS unsigned*)(lds + (bufoff) + ldsw + _i * 8192), 16, 0, 0); } while (0)
#define PG8_LDA(dst, b, h) do { _Pragma("unroll") for (int m = 0; m < 4; ++m) _Pragma("unroll") for (int k = 0; k < 2; ++k) dst[m][k] = *(const PG8_LAS bf16x8*)(lds + PG8_SA(b, h) + aoff + m * 2048 + k * 1024); } while (0)
#define PG8_LDB(dst, b, h) do { _Pragma("unroll") for (int n = 0; n < 2; ++n) _Pragma("unroll") for (int k = 0; k < 2; ++k) dst[n][k] = *(const PG8_LAS bf16x8*)(lds + PG8_SB(b, h) + boff + n * 2048 + k * 1024); } while (0)
#define PG8_MMA(ai, bj, At, Bt) do { __builtin_amdgcn_s_setprio(1); _Pragma("unroll") for (int m = 0; m < 4; ++m) _Pragma("unroll") for (int n = 0; n < 2; ++n) _Pragma("unroll") for (int k = 0; k < 2; ++k) \
        acc[ai][bj][m][n] = __builtin_amdgcn_mfma_f32_16x16x32_bf16(Bt[n][k], At[m][k], acc[ai][bj][m][n], 0, 0, 0); __builtin_amdgcn_s_setprio(0); } while (0)
#define PG8_WAIT_V(n) asm volatile("s_waitcnt vmcnt(" #n ")" ::: "memory")
#define PG8_WAIT_L(n) asm volatile("s_waitcnt lgkmcnt(" #n ")" ::: "memory")
#define PG8_BAR __builtin_amdgcn_s_barrier()
#define PG8_SCHED __builtin_amdgcn_sched_barrier(0)
    Unit cur, nxt; int ui = 0;
    if (!S.next(0, cur)) return;
    f32x4 acc[2][2][4][2];
#pragma unroll
    for (int a = 0; a < 2; ++a)
#pragma unroll
        for (int b = 0; b < 2; ++b)
#pragma unroll
            for (int m = 0; m < 4; ++m)
#pragma unroll
                for (int n = 0; n < 2; ++n) acc[a][b][m][n] = (f32x4){0.f, 0.f, 0.f, 0.f};
    bf16x8 At[4][2], B0[2][2], B1[2][2];
    const char* cA = (const char*)g.A + (size_t)cur.pm * tstep; const char* cB = (const char*)g.Bt + (size_t)cur.pn * tstep;
    S.a_ready(cur);
    if constexpr (SP2) {
        PG8_STAGE(PG8_SB(0, 0), cB, voffB); PG8_STAGE(PG8_SB(0, 1), cB + hstep, voffB); PG8_STAGE(PG8_SA(0, 0), cA, voffA); PG8_STAGE(PG8_SA(0, 1), cA + hstep, voffA);
        if (wr == 1) PG8_BAR;
        PG8_WAIT_V(2); PG8_BAR;
        PG8_STAGE(PG8_SB(1, 0), cB + kstep, voffB); PG8_STAGE(PG8_SA(1, 0), cA + kstep, voffA); PG8_STAGE(PG8_SB(1, 1), cB + hstep + kstep, voffB);
        PG8_WAIT_V(6); PG8_BAR;
    } else {
        PG8_STAGE(PG8_SB(0, 0), cB, voffB); PG8_STAGE(PG8_SA(0, 0), cA, voffA); PG8_STAGE(PG8_SB(0, 1), cB + hstep, voffB); PG8_STAGE(PG8_SA(0, 1), cA + hstep, voffA);
        if (wr == 1) PG8_BAR;
        PG8_WAIT_V(4); PG8_BAR;
        PG8_STAGE(PG8_SB(1, 0), cB + kstep, voffB); PG8_STAGE(PG8_SA(1, 0), cA + kstep, voffA); PG8_STAGE(PG8_SB(1, 1), cB + hstep + kstep, voffB);
        PG8_WAIT_V(6); PG8_BAR;
    }
    for (;;) {
        const bool has_next = S.next(ui + 1, nxt);
        const char* nA = has_next ? (const char*)g.A + (size_t)nxt.pm * tstep : cA; const char* nB = has_next ? (const char*)g.Bt + (size_t)nxt.pn * tstep : cB;
        for (int t = 0; t < nt; t += 2) {
            const bool last = (t == nt - 2);
            const char* a1 = cA + (size_t)(t + 1) * kstep;
            const char* a2 = last ? nA : cA + (size_t)(t + 2) * kstep; const char* b2 = last ? nB : cB + (size_t)(t + 2) * kstep;
            const char* a3 = a2 + kstep; const char* b3 = b2 + kstep;
            if (last && has_next) S.a_ready(nxt);
            if constexpr (SP2) {
            PG8_LDB(B0, 0, 0); PG8_LDB(B1, 0, 1); PG8_SCHED; PG8_LDA(At, 0, 0); PG8_STAGE(PG8_SA(1, 1), a1 + hstep, voffA);
            PG8_WAIT_V(8); PG8_WAIT_L(0); PG8_BAR; PG8_MMA(0, 0, At, B0); PG8_MMA(0, 1, At, B1); PG8_BAR; PG8_SCHED;
            PG8_LDA(At, 0, 1); PG8_STAGE(PG8_SB(0, 0), b2, voffB); PG8_STAGE(PG8_SB(0, 1), b2 + hstep, voffB); PG8_STAGE(PG8_SA(0, 0), a2, voffA);
            PG8_WAIT_V(8); PG8_WAIT_L(0); PG8_BAR; PG8_MMA(1, 0, At, B0); PG8_MMA(1, 1, At, B1); PG8_BAR; PG8_SCHED;
            PG8_LDB(B0, 1, 0); PG8_LDB(B1, 1, 1); PG8_SCHED; PG8_LDA(At, 1, 0); PG8_STAGE(PG8_SA(0, 1), a2 + hstep, voffA);
            PG8_WAIT_V(8); PG8_WAIT_L(0); PG8_BAR; PG8_MMA(0, 0, At, B0); PG8_MMA(0, 1, At, B1); PG8_BAR; PG8_SCHED;
            PG8_LDA(At, 1, 1); PG8_STAGE(PG8_SB(1, 0), b3, voffB); PG8_STAGE(PG8_SB(1, 1), b3 + hstep, voffB); PG8_STAGE(PG8_SA(1, 0), a3, voffA);
            PG8_WAIT_V(8); PG8_WAIT_L(0); PG8_BAR; PG8_MMA(1, 0, At, B0); PG8_MMA(1, 1, At, B1); PG8_BAR; PG8_SCHED;
            } else {
            PG8_LDB(B0, 0, 0); PG8_SCHED; PG8_LDA(At, 0, 0); PG8_STAGE(PG8_SA(1, 1), a1 + hstep, voffA);
            PG8_WAIT_L(8); PG8_BAR; PG8_WAIT_L(0); PG8_MMA(0, 0, At, B0); PG8_BAR; PG8_SCHED;
            PG8_LDB(B1, 0, 1); PG8_STAGE(PG8_SB(0, 0), b2, voffB);
            PG8_BAR; PG8_WAIT_L(0); PG8_MMA(0, 1, At, B1); PG8_BAR;
            PG8_LDA(At, 0, 1); PG8_STAGE(PG8_SA(0, 0), a2, voffA);
            PG8_BAR; PG8_WAIT_L(0); PG8_MMA(1, 0, At, B0); PG8_BAR; PG8_SCHED;
            PG8_STAGE(PG8_SB(0, 1), b2 + hstep, voffB);
            PG8_WAIT_V(6); PG8_BAR; PG8_MMA(1, 1, At, B1); PG8_BAR;
            PG8_LDB(B0, 1, 0); PG8_SCHED; PG8_LDA(At, 1, 0); PG8_STAGE(PG8_SA(0, 1), a2 + hstep, voffA);
            PG8_WAIT_L(8); PG8_BAR; PG8_WAIT_L(0); PG8_MMA(0, 0, At, B0); PG8_BAR; PG8_SCHED;
            PG8_LDB(B1, 1, 1); PG8_STAGE(PG8_SB(1, 0), b3, voffB);
            PG8_BAR; PG8_WAIT_L(0); PG8_MMA(0, 1, At, B1); PG8_BAR;
            PG8_LDA(At, 1, 1); PG8_STAGE(PG8_SA(1, 0), a3, voffA);
            PG8_BAR; PG8_WAIT_L(0); PG8_MMA(1, 0, At, B0); PG8_BAR; PG8_SCHED;
            PG8_STAGE(PG8_SB(1, 1), b3 + hstep, voffB);
            PG8_WAIT_V(6); PG8_BAR; PG8_MMA(1, 1, At, B1); PG8_BAR;
            }
        }
        if constexpr (ALIGN_EPI) { if (wr == 0) PG8_BAR; }
        if constexpr (!Epi::AFTER_DRAIN) { E(acc, cur, wr, wc, fr, fq); S.done(cur); }
        if (!has_next) break;
#pragma unroll
        for (int a = 0; a < 2; ++a)
#pragma unroll
            for (int b = 0; b < 2; ++b)
#pragma unroll
                for (int m = 0; m < 4; ++m)
#pragma unroll
                    for (int n = 0; n < 2; ++n) acc[a][b][m][n] = (f32x4){0.f, 0.f, 0.f, 0.f};
        cur = nxt; cA = nA; cB = nB; ++ui;
        if constexpr (ALIGN_EPI) { if (wr == 1) PG8_BAR; }
    }
    PG8_WAIT_V(0);
    if constexpr (!ALIGN_EPI) { if (wr == 0) PG8_BAR; }
    PG8_BAR;
    if constexpr (Epi::AFTER_DRAIN) { E.fused(acc, cur, wr, wc, fr, fq, lds, wid, lane); S.done(cur); }
#undef PG8_SA
#undef PG8_SB
#undef PG8_STAGE
#undef PG8_LDA
#undef PG8_LDB
#undef PG8_MMA
#undef PG8_WAIT_V
#undef PG8_WAIT_L
#undef PG8_BAR
#undef PG8_SCHED
}
}

constexpr int NWAVES = 8;
constexpr int BATCH = 2, SEQ = 8192, DM = 2048, DFF = 5504, HD = 128;
constexpr int M = BATCH * SEQ;
constexpr int NQKV = 3 * DM, NKV = 2 * DM, NWI = 2 * DFF;
constexpr float EPS = 1e-6f;
constexpr float ATT_SCALE = 0.08838834764831845f;

constexpr size_t MiB = 1u << 20;
constexpr size_t WS_CTL = 0, CTL_ZERO_BYTES = 1 * MiB;
constexpr size_t SZ_WI = (size_t)NWI * DM * 2, SZ_WO = (size_t)DM * DFF * 2;
constexpr size_t WS_WI_PRE = 2 * MiB, WS_WI_POST = WS_WI_PRE + 4 * SZ_WI, WS_WO_PRE = WS_WI_POST + 4 * SZ_WI, WS_WO_POST = WS_WO_PRE + 4 * SZ_WO;
constexpr size_t WS_AWQKV = WS_WO_POST + 4 * SZ_WO, SZ_AWQKV = (size_t)NQKV * DM * 2;
constexpr size_t WS_AWO = WS_AWQKV + 2 * SZ_AWQKV, SZ_DD = (size_t)DM * DM * 2;
constexpr size_t WS_BWKV = WS_AWO + 2 * SZ_DD, WS_BWQ = WS_BWKV + 2 * SZ_DD, WS_BWO = WS_BWQ + 2 * SZ_DD;
constexpr size_t WS_LUT = WS_BWO + 2 * SZ_DD;
constexpr size_t WS_XN = WS_LUT + 1 * MiB, SZ_MD = (size_t)M * DM * 2;
constexpr size_t WS_OB = WS_XN + SZ_MD;
constexpr size_t WS_H = WS_OB + SZ_MD, SZ_H = (size_t)M * DFF * 2;
constexpr size_t WS_QKV = WS_H + SZ_H, SZ_QKV = (size_t)M * NQKV * 2;
constexpr size_t WS_KVSH = WS_QKV + SZ_QKV, SZ_KVSH = (size_t)M * NKV * 2;
constexpr size_t WS_END = WS_KVSH + SZ_KVSH;
constexpr int CW_TMO = 0, CW_CODE = 1;
constexpr int CW_BAR = 4096;
constexpr int RING_OFF = 0, RING_BYTES = 131072;
constexpr int LDSCTL_OFF = RING_BYTES, MISC_OFF = LDSCTL_OFF + 320;
constexpr int LDS_BYTES = 147456;
static_assert(MISC_OFF + 128 <= LDS_BYTES, "LDS map");

#define GAS __attribute__((address_space(1)))
#define LAS __attribute__((address_space(3)))
typedef unsigned short bf16;
typedef unsigned v4u __attribute__((ext_vector_type(4)));
typedef float f32x4 __attribute__((ext_vector_type(4)));
typedef short bf16x8 __attribute__((ext_vector_type(8)));
typedef GAS unsigned gu32;
typedef GAS unsigned long long gu64;
#define RLX_AGENT __ATOMIC_RELAXED, __HIP_MEMORY_SCOPE_AGENT
#define LDS_WAIT() asm volatile("s_waitcnt lgkmcnt(0)" ::: "memory")
#define VM_WAIT() asm volatile("s_waitcnt vmcnt(0)" ::: "memory")
__device__ __forceinline__ unsigned long long rt() { return __builtin_amdgcn_s_memrealtime(); }
__device__ __forceinline__ unsigned f2bf(float f) { unsigned u = __builtin_bit_cast(unsigned, f); return (u + 0x7fffu + ((u >> 16) & 1u)) >> 16; }
__device__ __forceinline__ unsigned pk2(float lo, float hi) { return f2bf(lo) | (f2bf(hi) << 16); }

#define XB_TMO      128
#define XB_XCNT(j)  (256  + 64 * (j))
#define XB_XSUB(j)  (1280 + 64 * (j))
#define XB_XGEN(j)  (2304 + 64 * (j))
#define XB_TOP      3328
#define XB_TOPGEN   3392
#define XCD_BAR_WORDS 3456
#define XB_SPIN_CAP (1u << 18)

__device__ __forceinline__ unsigned xb_ld(unsigned* p)              { return __hip_atomic_load(p, __ATOMIC_RELAXED, __HIP_MEMORY_SCOPE_AGENT); }
__device__ __forceinline__ unsigned xb_add(unsigned* p, unsigned v) { return __hip_atomic_fetch_add(p, v, __ATOMIC_RELAXED, __HIP_MEMORY_SCOPE_AGENT); }
__device__ __forceinline__ unsigned xb_xcc_id() { return (unsigned)__builtin_amdgcn_s_getreg((3 << 11) | 20) & 0xFu; }
#define XB_SPIN(cond, bar) do { unsigned _sp = 0; while (cond) { __builtin_amdgcn_s_sleep(1); \
    if ((++_sp & 255u) == 0u) { if (xb_ld(&(bar)[XB_TMO])) break; if (_sp > XB_SPIN_CAP) { atomicAdd(&(bar)[XB_TMO], 1u); break; } } } } while (0)

struct XcdBarrier {
    unsigned* bar; unsigned x;
    volatile LAS unsigned* st;
};

__device__ __forceinline__ XcdBarrier xcd_barrier_post(unsigned* bar, volatile LAS unsigned* st) {
    XcdBarrier b; b.bar = bar; b.x = xb_xcc_id(); b.st = st;
    if (threadIdx.x == 0) (void)xb_add(&bar[XB_XCNT(b.x)], 1u);
    return b;
}
__device__ __forceinline__ void xcd_barrier_complete(unsigned* bar, unsigned x, unsigned& nloc, unsigned& nx) {
    const unsigned G = gridDim.x * gridDim.y * gridDim.z;
    unsigned sum, cnt, mine, sp = 0u;
    for (;;) {
        sum = 0u; cnt = 0u; mine = 0u;
#pragma unroll
        for (unsigned j = 0; j < 16; ++j) { const unsigned c = xb_ld(&bar[XB_XCNT(j)]); sum += c; cnt += (c > 0u) ? 1u : 0u; mine = (j == x) ? c : mine; }
        if (sum == G) break;
        __builtin_amdgcn_s_sleep(1);
        if ((++sp & 255u) == 0u) { if (xb_ld(&bar[XB_TMO])) break; if (sp > XB_SPIN_CAP) { atomicAdd(&bar[XB_TMO], 1u); break; } }
    }
    nloc = mine > 0u ? mine : 1u; nx = cnt > 0u ? cnt : 1u;
}

__device__ __forceinline__ void xcd_barrier(const XcdBarrier& b) {
    asm volatile("s_waitcnt vmcnt(0)" ::: "memory");
    __syncthreads();
    if (threadIdx.x == 0) {
        unsigned* bar = b.bar;
        __builtin_amdgcn_s_waitcnt(0);
        unsigned nloc = b.st[0], nx = b.st[1];
        if (nloc == 0u) { xcd_barrier_complete(bar, b.x, nloc, nx); b.st[0] = nloc; b.st[1] = nx; }
        const unsigned old = xb_add(&bar[XB_XSUB(b.x)], 1u);
        const unsigned gen = old / nloc;
        if (old + 1u == (gen + 1u) * nloc) {
            __builtin_amdgcn_fence(__ATOMIC_RELEASE, "agent");
            asm volatile("s_waitcnt vmcnt(0)" ::: "memory");
            const unsigned og = xb_add(&bar[XB_TOP], 1u);
            const unsigned tg = og / nx;
            if (og + 1u == (tg + 1u) * nx) xb_add(&bar[XB_TOPGEN], 1u);
            else XB_SPIN(xb_ld(&bar[XB_TOPGEN]) == tg, bar);
            __builtin_amdgcn_fence(__ATOMIC_ACQUIRE, "agent");
            xb_add(&bar[XB_XGEN(b.x)], 1u);
            asm volatile("s_waitcnt vmcnt(0)" ::: "memory");
        } else {
            XB_SPIN(xb_ld(&bar[XB_XGEN(b.x)]) == gen, bar);
            __builtin_amdgcn_fence(__ATOMIC_ACQUIRE, "agent");
            asm volatile("s_waitcnt vmcnt(0)" ::: "memory");
        }
    }
    __syncthreads();
}

struct Args { const float* in[19]; float* out; unsigned char* ws; };
__device__ __forceinline__ int launder_v(int v) { asm volatile("" : "+v"(v)); return v; }
struct Frame {
    LAS unsigned char* lds;
    volatile LAS unsigned* MISC;
    gu32* ctl;
    int tid, lane, wave;
    int vcu, G;
};
__device__ __forceinline__ float wave_sum(float v) {
#pragma unroll
    for (int o = 1; o < 64; o <<= 1) { int oo = o; asm volatile("" : "+v"(oo)); v += __shfl_xor(v, oo); }
    return v;
}
__device__ __forceinline__ float wave_max(float v) {
#pragma unroll
    for (int o = 1; o < 64; o <<= 1) { int oo = o; asm volatile("" : "+v"(oo)); v = fmaxf(v, __shfl_xor(v, oo)); }
    return v;
}
__device__ __forceinline__ float bf2f(unsigned short h) { return __uint_as_float((unsigned)h << 16); }
__device__ __forceinline__ float bflo(unsigned w) { return __uint_as_float(w << 16); }
__device__ __forceinline__ float bfhi(unsigned w) { return __uint_as_float(w & 0xffff0000u); }

__device__ __forceinline__ int t5_bucket(int n) {
    if (n < 16) return n;
    if (n >= 113) return 31;
    int b = 16;
    b += (n >= 19); b += (n >= 21); b += (n >= 24); b += (n >= 27); b += (n >= 31); b += (n >= 35); b += (n >= 40); b += (n >= 46);
    b += (n >= 52); b += (n >= 59); b += (n >= 67); b += (n >= 77); b += (n >= 87); b += (n >= 99);
    return b;
}

__device__ __forceinline__ void p0_transpose_item(const float* W, int K, int N, bf16* WT, int k0, int n0, int drow0, LAS float* scr, int lane) {
#pragma unroll 8
    for (int i = 0; i < 32; ++i) { const int kk = 2 * i + (lane >> 5); scr[kk * 33 + (lane & 31)] = W[(size_t)(k0 + kk) * N + n0 + (lane & 31)]; }
    LDS_WAIT(); asm volatile("" ::: "memory");
    const int c = lane & 7;
#pragma unroll
    for (int j = 0; j < 4; ++j) { const int n = (lane >> 3) + 8 * j; const LAS float* s = scr + (8 * c) * 33 + n;
        v4u o; o.x = pk2(s[0 * 33], s[1 * 33]); o.y = pk2(s[2 * 33], s[3 * 33]); o.z = pk2(s[4 * 33], s[5 * 33]); o.w = pk2(s[6 * 33], s[7 * 33]);
        *(GAS v4u*)(WT + (size_t)(drow0 + n) * K + k0 + 8 * c) = o; }
    LDS_WAIT(); asm volatile("" ::: "memory");
}
template <bool GLU>
__device__ __forceinline__ void transpose_group(Frame& F, const float* W, int L, int K, int N, bf16* WT, LAS float* scr) {
    const int gw = F.vcu * NWAVES + F.wave, NGW = F.G * NWAVES; const int lane = launder_v(F.lane);
    const int nblk = N / 32, kblk = K / 64, per = nblk * kblk, total = L * per;
    for (int it = gw; it < total; it += NGW) {
        const int l = it / per, r = it - l * per, kb = r / nblk, nb = r - kb * nblk, n0 = nb * 32;
        int drow0 = n0;
        if (GLU) { const int half = N / 2; const int c = n0 >= half ? n0 - half : n0; drow0 = (c >> 7) * 256 + (n0 >= half ? 128 : 0) + (c & 127); }
        p0_transpose_item(W + (size_t)l * K * N, K, N, WT + (size_t)l * K * N, kb * 64, n0, drow0, scr, lane);
    }
}
__device__ __forceinline__ void norm_rows(Frame& F, const float* x, const float* g, bf16* out) {
    const int gw = F.vcu * NWAVES + F.wave, NGW = F.G * NWAVES; const int lane = launder_v(F.lane);
    f32x4 gv[8];
#pragma unroll
    for (int j = 0; j < 8; ++j) gv[j] = ((const GAS f32x4*)g)[lane + 64 * j];
    for (int m = gw; m < M; m += NGW) {
        const GAS f32x4* xr = (const GAS f32x4*)(x + (size_t)m * DM) + lane;
        f32x4 v[8]; float s = 0.f;
#pragma unroll
        for (int j = 0; j < 8; ++j) { v[j] = xr[64 * j]; s += (v[j].x * v[j].x + v[j].y * v[j].y) + (v[j].z * v[j].z + v[j].w * v[j].w); }
        const float rstd = 1.0f / sqrtf(wave_sum(s) * (1.f / DM) + EPS);
        GAS unsigned long long* o8 = (GAS unsigned long long*)(out + (size_t)m * DM) + lane;
#pragma unroll
        for (int j = 0; j < 8; ++j) { const f32x4 y = v[j] * rstd * gv[j];
            o8[64 * j] = (unsigned long long)pk2(y.x, y.y) | ((unsigned long long)pk2(y.z, y.w) << 32); }
    }
}
__device__ __forceinline__ void qknorm_rows(Frame& F, bf16* QKV, const float* qg, const float* kg) {
    const int gw = F.vcu * NWAVES + F.wave, NGW = F.G * NWAVES; const int lane = launder_v(F.lane);
    const int sub = lane & 15;
    const f32x4 q0 = *(const GAS f32x4*)(qg + sub * 8), q1 = *(const GAS f32x4*)(qg + sub * 8 + 4), k0 = *(const GAS f32x4*)(kg + sub * 8), k1 = *(const GAS f32x4*)(kg + sub * 8 + 4);
    for (int it = gw; it < M * 8; it += NGW) {
        const int m = it >> 3, grp = it & 7;
        bf16* p = QKV + (size_t)m * NQKV + grp * 512 + lane * 8;
        const v4u w = *(const GAS v4u*)p;
        float f[8] = {bflo(w.x), bfhi(w.x), bflo(w.y), bfhi(w.y), bflo(w.z), bfhi(w.z), bflo(w.w), bfhi(w.w)};
        float s = 0.f;
#pragma unroll
        for (int i = 0; i < 8; ++i) s += f[i] * f[i];
#pragma unroll
        for (int o = 1; o < 16; o <<= 1) { int oo = o; asm volatile("" : "+v"(oo)); s += __shfl_xor(s, oo); }
        const float rstd = 1.0f / sqrtf(s * (1.f / HD) + EPS);
        const bool isk = grp >= 4; const f32x4 g0 = isk ? k0 : q0, g1 = isk ? k1 : q1;
        v4u o; o.x = pk2(f[0] * rstd * g0.x, f[1] * rstd * g0.y); o.y = pk2(f[2] * rstd * g0.z, f[3] * rstd * g0.w);
        o.z = pk2(f[4] * rstd * g1.x, f[5] * rstd * g1.y); o.w = pk2(f[6] * rstd * g1.z, f[7] * rstd * g1.w);
        *(GAS v4u*)p = o;
    }
}
__device__ __forceinline__ float dot8(const v4u w, const LAS float* q) {
    const f32x4 a = *(const LAS f32x4*)q, b = *(const LAS f32x4*)(q + 4);
    return (bflo(w.x) * a.x + bfhi(w.x) * a.y) + (bflo(w.y) * a.z + bfhi(w.y) * a.w) + (bflo(w.z) * b.x + bfhi(w.z) * b.y) + (bflo(w.w) * b.z + bfhi(w.w) * b.w);
}
__device__ __forceinline__ void attnA_naive(Frame& F, const bf16* QKV, bf16* O, const float* lamv, const float* subln, const float* lut, float lambda_init) {
    LAS float* qs = (LAS float*)(F.lds + RING_OFF + F.wave * 2048);
    const int lane = launder_v(F.lane);
    float s01 = 0.f, s23 = 0.f;
    for (int i = lane; i < 128; i += 64) { s01 += lamv[i] * lamv[128 + i]; s23 += lamv[256 + i] * lamv[384 + i]; }
    s01 = wave_sum(s01); s23 = wave_sum(s23);
    const float lam = expf(s01) - expf(s23) + lambda_init, oml = 1.0f - lambda_init;
    const f32x4 gsub = *(const GAS f32x4*)(subln + 4 * lane);
    const int gw = F.vcu * NWAVES + F.wave, NGW = F.G * NWAVES;
    for (int it = gw; it < BATCH * 8 * SEQ; it += NGW) {
        const int bh = it & 15, t = SEQ - 1 - (it >> 4), b = bh >> 3, h = bh & 7;
        const bf16* Qr = QKV + (size_t)(b * SEQ + t) * NQKV + h * 256;
        { const unsigned long long w = *(const GAS unsigned long long*)(Qr + 4 * lane); const unsigned lo = (unsigned)w, hi = (unsigned)(w >> 32);
          *(LAS f32x4*)(qs + 4 * lane) = (f32x4){bflo(lo), bfhi(lo), bflo(hi), bfhi(hi)}; }
        LDS_WAIT(); asm volatile("" ::: "memory");
        float m1 = -1e30f, m2 = -1e30f, l1 = 0.f, l2 = 0.f; f32x4 o1 = {0.f, 0.f, 0.f, 0.f}, o2 = {0.f, 0.f, 0.f, 0.f};
        const float* lut1 = lut + (2 * h) * 128; const float* lut2 = lut1 + 128;
        for (int s0 = 0; s0 <= t; s0 += 64) {
            const int s = s0 + lane; const bool valid = s <= t; const int sc = valid ? s : t;
            const bf16* kr = QKV + (size_t)(b * SEQ + sc) * NQKV + DM + h * 256;
            LAS float* qs_ = qs; asm volatile("" : "+v"(qs_));
            float d1 = 0.f, d2 = 0.f;
#pragma unroll 2
            for (int c = 0; c < 16; ++c) { d1 += dot8(*(const GAS v4u*)(kr + 8 * c), qs_ + 8 * c); d2 += dot8(*(const GAS v4u*)(kr + 128 + 8 * c), qs_ + 128 + 8 * c); }
            int n = t - sc; n = n > 113 ? 113 : n;
            const float x1 = valid ? d1 * ATT_SCALE + lut1[n] : -INFINITY, x2 = valid ? d2 * ATT_SCALE + lut2[n] : -INFINITY;
            const float mn1 = fmaxf(m1, wave_max(x1)), mn2 = fmaxf(m2, wave_max(x2));
            const float a1 = expf(m1 - mn1), a2 = expf(m2 - mn2);
            const float p1 = valid ? expf(x1 - mn1) : 0.f, p2 = valid ? expf(x2 - mn2) : 0.f;
            l1 = l1 * a1 + wave_sum(p1); l2 = l2 * a2 + wave_sum(p2); m1 = mn1; m2 = mn2;
            o1 = o1 * a1; o2 = o2 * a2;
            const int cnt = (t - s0 + 1) < 64 ? (t - s0 + 1) : 64;
            const bf16* vr = QKV + (size_t)(b * SEQ + s0) * NQKV + 2 * DM + h * 256 + 4 * lane;
            for (int j = 0; j < cnt; ++j) {
                const float pj1 = __shfl(p1, j), pj2 = __shfl(p2, j);
                const unsigned long long w = *(const GAS unsigned long long*)(vr + (size_t)j * NQKV); const unsigned lo = (unsigned)w, hi = (unsigned)(w >> 32);
                const f32x4 v = {bflo(lo), bfhi(lo), bflo(hi), bfhi(hi)};
                o1 = o1 + v * pj1; o2 = o2 + v * pj2;
            }
        }
        const float r1 = 1.0f / l1, r2 = lam / l2;
        const f32x4 o = o1 * r1 - o2 * r2;
        const float ss = wave_sum((o.x * o.x + o.y * o.y) + (o.z * o.z + o.w * o.w));
        const float rstd = 1.0f / sqrtf(ss * (1.f / 256.f) + EPS);
        const f32x4 y = o * rstd * gsub * oml;
        *(GAS unsigned long long*)(O + (size_t)(b * SEQ + t) * DM + h * 256 + 4 * lane) = (unsigned long long)pk2(y.x, y.y) | ((unsigned long long)pk2(y.z, y.w) << 32);
    }
}
__device__ __forceinline__ float log_sigmoid_f(float x) { return fminf(x, 0.f) - log1pf(expf(-fabsf(x))); }
__device__ __forceinline__ void attnB_naive(Frame& F, const bf16* Q, const bf16* KV, bf16* O) {
    LAS float* qs = (LAS float*)(F.lds + RING_OFF + F.wave * 2048);
    const int lane = launder_v(F.lane);
    const int gw = F.vcu * NWAVES + F.wave, NGW = F.G * NWAVES;
    for (int it = gw; it < BATCH * 16 * SEQ; it += NGW) {
        const int bh = it & 31, t = SEQ - 1 - (it >> 5), b = bh >> 4, h = bh & 15;
        const bf16* Qr = Q + (size_t)(b * SEQ + t) * DM + h * HD;
        { const unsigned w = *(const GAS unsigned*)(Qr + 2 * lane); qs[2 * lane] = bflo(w); qs[2 * lane + 1] = bfhi(w); }
        LDS_WAIT(); asm volatile("" ::: "memory");
        float o0 = 0.f, o1 = 0.f, C = 0.f;
        if (t > 0) {
            for (int s0 = ((t - 1) >> 6) << 6; s0 >= 0; s0 -= 64) {
                const int s = s0 + lane; const bool valid = s < t; const int sc = valid ? s : t - 1;
                const bf16* kr = KV + (size_t)(b * SEQ + sc) * NKV + h * HD;
                LAS float* qs_ = qs; asm volatile("" : "+v"(qs_));
                float d = 0.f;
#pragma unroll 4
                for (int c = 0; c < 16; ++c) d += dot8(*(const GAS v4u*)(kr + 8 * c), qs_ + 8 * c);
                const float z = d * ATT_SCALE;
                const float lk = valid ? log_sigmoid_f(-z) : 0.f, lb = log_sigmoid_f(z);
                float incl = lk;
#pragma unroll
                for (int off = 1; off < 64; off <<= 1) { int oo = off; asm volatile("" : "+v"(oo)); const float tmp = __shfl_down(incl, oo); incl += (lane + off < 64) ? tmp : 0.f; }
                const float suf = incl - lk, tot = __shfl(incl, 0);
                const float w = valid ? expf(lb + suf + C) : 0.f;
                C += tot;
                const int cnt = (t - s0) < 64 ? (t - s0) : 64;
                const bf16* vr = KV + (size_t)(b * SEQ + s0) * NKV + DM + h * HD + 2 * lane;
                for (int j = 0; j < cnt; ++j) {
                    const float wj = __shfl(w, j);
                    const unsigned vv = *(const GAS unsigned*)(vr + (size_t)j * NKV);
                    o0 += wj * bflo(vv); o1 += wj * bfhi(vv);
                }
            }
        }
        *(GAS unsigned*)(O + (size_t)(b * SEQ + t) * DM + h * HD + 2 * lane) = pk2(o0, o1);
    }
}

typedef const __attribute__((address_space(4))) Args* KArgs;
#define KARG() ({ KArgs ap_ = (KArgs)__builtin_amdgcn_kernarg_segment_ptr(); asm volatile("" : "+s"(ap_)); ap_; })
#define IN(k) (KARG()->in[k])
#define WS() (KARG()->ws)
__global__ void __launch_bounds__(NWAVES * 64, 2) mk_fwd(Args args_unused) {
    extern __shared__ __attribute__((aligned(16))) unsigned char lds[];
    Frame F;
    F.lds = (LAS unsigned char*)lds;
    F.MISC = (volatile LAS unsigned*)(F.lds + MISC_OFF);
    F.tid = threadIdx.x; F.lane = F.tid & 63; F.wave = __builtin_amdgcn_readfirstlane(F.tid >> 6);
    F.G = gridDim.x; { const int bx = blockIdx.x; F.vcu = (F.G % 8 == 0) ? (bx % 8) * (F.G / 8) + bx / 8 : bx; }
    F.ctl = (gu32*)(WS() + WS_CTL);
    for (int u = F.tid; u < (LDS_BYTES - LDSCTL_OFF) / 4; u += NWAVES * 64) ((LAS unsigned*)(F.lds + LDSCTL_OFF))[u] = 0u;
    __syncthreads();
    (void)xcd_barrier_post((unsigned*)(F.ctl + CW_BAR), F.MISC + 8);
#define GRID_BAR() do { XcdBarrier b_; b_.bar = (unsigned*)(WS() + WS_CTL) + CW_BAR; b_.x = xb_xcc_id(); b_.st = F.MISC + 8; xcd_barrier(b_); } while (0)
#define XO() (KARG()->out)
#define WSP(off) ((bf16*)(WS() + (off)))
#define XN WSP(WS_XN)
#define OB WSP(WS_OB)
#define HB WSP(WS_H)
#define QKV WSP(WS_QKV)
#define KVSH WSP(WS_KVSH)
#define LUT ((float*)(WS() + WS_LUT))

    {
        LAS float* scr = (LAS float*)(F.lds + RING_OFF + F.wave * 16384);
        transpose_group<true >(F, IN(2), 4, DM, NWI, (bf16*)(WS() + WS_WI_PRE), scr);
        transpose_group<false>(F, IN(3), 4, DFF, DM, (bf16*)(WS() + WS_WO_PRE), scr);
        transpose_group<true >(F, IN(6), 4, DM, NWI, (bf16*)(WS() + WS_WI_POST), scr);
        transpose_group<false>(F, IN(7), 4, DFF, DM, (bf16*)(WS() + WS_WO_POST), scr);
        transpose_group<false>(F, IN(9), 2, DM, NQKV, (bf16*)(WS() + WS_AWQKV), scr);
        transpose_group<false>(F, IN(14), 2, DM, DM, (bf16*)(WS() + WS_AWO), scr);
        transpose_group<false>(F, IN(16), 1, DM, NKV, (bf16*)(WS() + WS_BWKV), scr);
        transpose_group<false>(F, IN(17), 2, DM, DM, (bf16*)(WS() + WS_BWQ), scr);
        transpose_group<false>(F, IN(18), 2, DM, DM, (bf16*)(WS() + WS_BWO), scr);
        if (blockIdx.x == 0) { const float* rb = IN(8);
            for (int i = F.tid; i < 16 * 128; i += NWAVES * 64) { const int j = i >> 7, n = i & 127; LUT[i] = rb[t5_bucket(n) * 16 + j]; } }
        norm_rows(F, IN(0), IN(1), XN);
    }
    GRID_BAR();

    for (int l = 0; l < 4; ++l) {
        if (l == 2) {
            norm_rows(F, XO(), IN(15), OB);
            GRID_BAR();
            pg8::Gemm g{OB, (const bf16*)(WS() + WS_BWKV), M, NKV, DM}; pg8::StaticOrder S; S.init(M, NKV, F.G, (int)blockIdx.x);
            pg8::EpiBf16 E{KVSH, NKV};
            pg8::gemm_phase<pg8::EpiBf16, pg8::StaticOrder, true, true>(F.lds + RING_OFF, g, S, E);
            GRID_BAR();
        }
        for (int s = 0; s < 2; ++s) {
            {
                const bf16* wi = (const bf16*)(WS() + (s ? WS_WI_POST : WS_WI_PRE) + (size_t)l * SZ_WI);
                pg8::Gemm g{XN, wi, M, NWI, DM}; pg8::StaticOrder S; S.init(M, NWI, F.G, (int)blockIdx.x);
                pg8::EpiSwiGLU E{HB, DFF};
                pg8::gemm_phase<pg8::EpiSwiGLU, pg8::StaticOrder, true, true>(F.lds + RING_OFF, g, S, E);
            }
            GRID_BAR();
            {
                const bf16* wo = (const bf16*)(WS() + (s ? WS_WO_POST : WS_WO_PRE) + (size_t)l * SZ_WO);
                pg8::Gemm g{HB, wo, M, DM, DFF}; pg8::StaticOrder S; S.init(M, DM, F.G, (int)blockIdx.x);
                float* xo_ = XO(); pg8::EpiResid E{(l == 0 && s == 0) ? IN(0) : (const float*)xo_, xo_, DM, 0.5f};
                pg8::gemm_phase<pg8::EpiResid, pg8::StaticOrder, true, true>(F.lds + RING_OFF, g, S, E);
            }
            GRID_BAR();
            if (s == 0) {
                norm_rows(F, XO(), IN(4) + (size_t)l * DM, XN);
                GRID_BAR();
                {
                    const bool isA = l < 2;
                    const bf16* w = isA ? (const bf16*)(WS() + WS_AWQKV + (size_t)l * SZ_AWQKV) : (const bf16*)(WS() + WS_BWQ + (size_t)(l - 2) * SZ_DD);
                    const int N = isA ? NQKV : DM;
                    pg8::Gemm g{XN, w, M, N, DM}; pg8::StaticOrder S; S.init(M, N, F.G, (int)blockIdx.x);
                    pg8::EpiBf16 E{QKV, N};
                    pg8::gemm_phase<pg8::EpiBf16, pg8::StaticOrder, true, true>(F.lds + RING_OFF, g, S, E);
                }
                GRID_BAR();
                if (l < 2) {
                    qknorm_rows(F, QKV, IN(10) + (size_t)l * HD, IN(11) + (size_t)l * HD);
                    GRID_BAR();
                    attnA_naive(F, QKV, OB, IN(12) + (size_t)l * 512, IN(13) + (size_t)l * 256, LUT, l == 0 ? 0.2f : 0.35550906759096924f);
                } else {
                    attnB_naive(F, QKV, KVSH, OB);
                }
                GRID_BAR();
                {
                    const bf16* w = (l < 2) ? (const bf16*)(WS() + WS_AWO + (size_t)l * SZ_DD) : (const bf16*)(WS() + WS_BWO + (size_t)(l - 2) * SZ_DD);
                    pg8::Gemm g{OB, w, M, DM, DM}; pg8::StaticOrder S; S.init(M, DM, F.G, (int)blockIdx.x);
                    float* xo_ = XO(); pg8::EpiResid E{xo_, xo_, DM, 1.0f};
                    pg8::gemm_phase<pg8::EpiResid, pg8::StaticOrder, true, true>(F.lds + RING_OFF, g, S, E);
                }
                GRID_BAR();
                norm_rows(F, XO(), IN(5) + (size_t)l * DM, XN);
                GRID_BAR();
            } else if (l < 3) {
                norm_rows(F, XO(), IN(1) + (size_t)(l + 1) * DM, XN);
                GRID_BAR();
            }
        }
    }
#undef GRID_BAR
#undef XN
#undef OB
#undef HB
#undef QKV
#undef KVSH
#undef LUT
}

extern "C" void kernel_launch(void* const* d_in, const int* in_sizes, int n_in, void* d_out, int out_size, void* d_ws, size_t ws_size, hipStream_t stream) {
    static int grid = 0;
    if (grid == 0) {
        if (n_in != 19 || in_sizes[0] != M * DM || out_size != M * DM || ws_size < WS_END) { fprintf(stderr, "kernel_launch: shape/workspace mismatch: n_in %d in0 %d out %d ws %zu (need %zu); nothing launched\n", n_in, n_in > 0 ? in_sizes[0] : -1, out_size, ws_size, (size_t)WS_END); grid = -1; return; }
        int dev = 0, cus = 0, per_cu = 0;
        if (hipGetDevice(&dev) != hipSuccess || hipDeviceGetAttribute(&cus, hipDeviceAttributeMultiprocessorCount, dev) != hipSuccess) { fprintf(stderr, "kernel_launch: device query failed\n"); grid = -1; return; }
        if (hipFuncSetAttribute((const void*)mk_fwd, hipFuncAttributeMaxDynamicSharedMemorySize, LDS_BYTES) != hipSuccess) { fprintf(stderr, "kernel_launch: hipFuncSetAttribute failed\n"); grid = -1; return; }
        if (hipOccupancyMaxActiveBlocksPerMultiprocessor(&per_cu, (const void*)mk_fwd, NWAVES * 64, LDS_BYTES) != hipSuccess || per_cu < 1)
            fprintf(stderr, "kernel_launch: note: occupancy query reports %d workgroups per CU\n", per_cu);
        (void)hipGetLastError();
        grid = cus;
    }
    if (grid < 0) return;
    if (hipMemsetAsync((char*)d_ws + WS_CTL, 0, CTL_ZERO_BYTES, stream) != hipSuccess) { fprintf(stderr, "kernel_launch: memset failed\n"); return; }
    Args a{};
    for (int i = 0; i < 19; ++i) a.in[i] = (const float*)d_in[i];
    a.out = (float*)d_out; a.ws = (unsigned char*)d_ws;
    hipLaunchKernelGGL(mk_fwd, dim3(grid), dim3(NWAVES * 64), LDS_BYTES, stream, a);
    const hipError_t le = hipPeekAtLastError();
    if (le != hipSuccess) fprintf(stderr, "kernel_launch: launch failed: %s\n", hipGetErrorName(le));
}
```

```cpp
#include <hip/hip_runtime.h>
__device__ __forceinline__ int lane_id() { unsigned z; asm volatile("s_mov_b32 %0, 0" : "=s"(z)); return (int)__builtin_amdgcn_mbcnt_hi(~0u, __builtin_amdgcn_mbcnt_lo(~0u, z)); }
__device__ __forceinline__ float shx(float v, int o) { return __int_as_float(__builtin_amdgcn_ds_bpermute((lane_id() ^ o) << 2, __float_as_int(v))); }
#include <hip/hip_runtime.h>
#include <cstdio>
#include <cstdint>
namespace pg8 {
#define PG8_LAS __attribute__((address_space(3)))
typedef unsigned short bf16_t;
typedef short bf16x8 __attribute__((ext_vector_type(8)));
typedef float f32x4 __attribute__((ext_vector_type(4)));
typedef unsigned u32x4 __attribute__((ext_vector_type(4)));
constexpr int BM = 256, BK = 64, HALF = 128, HTB = HALF * BK * 2  , STAGE_BYTES = 8 * HTB, NXCD = 8, WGM = 8;

__host__ __device__ __forceinline__ int lds_byte(int r, int c) { const int st = (r >> 4) * 2 + (c >> 5), rr = r & 15, cc = c & 31, ob = rr * 64 + cc * 2; return st * 1024 + (ob ^ (((ob >> 9) & 1) << 5)); }
__host__ __device__ __forceinline__ void stage_rc(int b, int& R, int& C) { const int st = b / 1024, sb = b % 1024, swz = sb ^ (((sb >> 9) & 1) << 5); R = (st >> 1) * 16 + swz / 64; C = (st & 1) * 32 + (swz % 64) / 2; }
__host__ __device__ __forceinline__ int perm32(int rho) { const int n = rho >> 4, i = rho & 15; return 8 * (i >> 2) + 4 * n + (i & 3); }

struct Unit { int pm, pn, idx; };
struct Gemm { const bf16_t* A; const bf16_t* Bt; int M, N, K; };

struct StaticOrder {
    int nM, nN, nwg, G, c;
    __host__ __device__ void init(int M, int N, int G_, int c_) { nM = M / BM; nN = N / BM; nwg = nM * nN; G = G_; c = c_; }
    __host__ __device__ bool next(int i, Unit& u) const {
        const long L = (long)i * G + c; if (L >= nwg) return false;
        int wgid = (int)L; { const int q = nwg / NXCD, r = nwg % NXCD, xcd = wgid % NXCD, off = wgid / NXCD; wgid = (xcd < r ? xcd * (q + 1) : r * (q + 1) + (xcd - r) * q) + off; }
        const int nig = WGM * nN, gid = wgid / nig, fm = gid * WGM, gsz = (nM - fm) < WGM ? (nM - fm) : WGM;
        u.pm = fm + ((wgid % nig) % gsz); u.pn = (wgid % nig) / gsz; u.idx = i; return true;
    }
    __device__ __forceinline__ void a_ready(const Unit&) const {}
    __device__ __forceinline__ void done(const Unit&) const {}
};

__device__ __forceinline__ unsigned cvt_pk_bf16(float lo, float hi) { unsigned r; asm volatile("v_cvt_pk_bf16_f32 %0, %1, %2" : "=v"(r) : "v"(lo), "v"(hi)); return r; }
template <class Sched>
__device__ __forceinline__ void preload_rstd(const Sched& S, const float* ss, PG8_LAS float* rs, int tid) {
    Unit u; const int sub = tid & 7;
    for (int i = 0; S.next(i, u); ++i)
        for (int r = tid >> 3; r < 256; r += 64) {
            const f32x4 a = *(const f32x4*)(ss + (size_t)(u.pm * BM + r) * 32 + sub * 4); float s = (a[0] + a[1]) + (a[2] + a[3]);
            s += shx(s, 1); s += shx(s, 2); s += shx(s, 4);
            if (sub == 0) rs[i * 256 + r] = __builtin_amdgcn_rsqf(s * (1.0f / 2048.0f) + 1e-6f); }
    asm volatile("s_waitcnt lgkmcnt(0)" ::: "memory"); __syncthreads();
}
__device__ __forceinline__ void row_rstd(float (&rs)[2][4], const PG8_LAS float* tab, const Unit& u, int wr, int fr) {
#pragma unroll
    for (int ai = 0; ai < 2; ++ai)
#pragma unroll
        for (int m = 0; m < 4; ++m) rs[ai][m] = tab[u.idx * 256 + ai * HALF + wr * 64 + m * 16 + fr];
}
struct EpiBf16 {
    static constexpr bool PERM = true, AFTER_DRAIN = false;
    bf16_t* O; int ldc; const PG8_LAS float* rstab;
    __device__ __forceinline__ void operator()(const f32x4 (&acc)[2][2][4][2], const Unit& u, int wr, int wc, int fr, int fq) const {
        const int row0 = u.pm * BM + wr * 64 + fr, col0 = u.pn * BM + wc * 32 + 8 * fq;
        float rs[2][4]; row_rstd(rs, rstab, u, wr, fr);
#pragma unroll
        for (int ai = 0; ai < 2; ++ai)
#pragma unroll
            for (int m = 0; m < 4; ++m) { bf16_t* rowp = O + (size_t)(row0 + ai * HALF + m * 16) * ldc + col0; const float r = rs[ai][m];
#pragma unroll
                for (int bj = 0; bj < 2; ++bj) { const f32x4 v0 = acc[ai][bj][m][0] * r, v1 = acc[ai][bj][m][1] * r;
                    u32x4 w; w.x = cvt_pk_bf16(v0[0], v0[1]); w.y = cvt_pk_bf16(v0[2], v0[3]); w.z = cvt_pk_bf16(v1[0], v1[1]); w.w = cvt_pk_bf16(v1[2], v1[3]);
                    *(u32x4*)(rowp + bj * HALF) = w; } }
    }
};
struct EpiQKV {
    static constexpr bool PERM = true, AFTER_DRAIN = false;
    bf16_t* O; int ldc; PG8_LAS float* xs; const PG8_LAS float* gains; const PG8_LAS float* rstab;
    __device__ __forceinline__ void operator()(const f32x4 (&acc)[2][2][4][2], const Unit& u, int wr, int wc, int fr, int fq) const {
        const int row0 = u.pm * BM + wr * 64 + fr, col0 = u.pn * BM + wc * 32 + 8 * fq;
        const bool nrm = u.pn < 16;
        float rs[2][4]; row_rstd(rs, rstab, u, wr, fr);
        if (nrm) {
#pragma unroll
            for (int ai = 0; ai < 2; ++ai)
#pragma unroll
                for (int m = 0; m < 4; ++m)
#pragma unroll
                    for (int bj = 0; bj < 2; ++bj) { const f32x4 a = acc[ai][bj][m][0] * rs[ai][m], b = acc[ai][bj][m][1] * rs[ai][m];
                        float s = ((a[0] * a[0] + a[1] * a[1]) + (a[2] * a[2] + a[3] * a[3])) + ((b[0] * b[0] + b[1] * b[1]) + (b[2] * b[2] + b[3] * b[3]));
                        s += shx(s, 16); s += shx(s, 32);
                        if (fq == 0) xs[(((wr * 128 + ai * 64 + m * 16 + fr) * 2 + bj) << 2) + wc] = s; }
        }
        asm volatile("s_waitcnt lgkmcnt(0)" ::: "memory"); __builtin_amdgcn_s_barrier(); asm volatile("" ::: "memory");
        f32x4 g0 = {1.f, 1.f, 1.f, 1.f}, g1 = g0;
        if (nrm) { const PG8_LAS float* gp = gains + (u.pn >= 8 ? 128 : 0) + wc * 32 + 8 * fq; g0 = *(const PG8_LAS f32x4*)gp; g1 = *(const PG8_LAS f32x4*)(gp + 4); }
#pragma unroll
        for (int ai = 0; ai < 2; ++ai)
#pragma unroll
            for (int m = 0; m < 4; ++m) { bf16_t* rowp = O + (size_t)(row0 + ai * HALF + m * 16) * ldc + col0;
#pragma unroll
                for (int bj = 0; bj < 2; ++bj) { f32x4 v0 = acc[ai][bj][m][0] * rs[ai][m], v1 = acc[ai][bj][m][1] * rs[ai][m];
                    if (nrm) { const f32x4 p = *(const PG8_LAS f32x4*)(xs + (((wr * 128 + ai * 64 + m * 16 + fr) * 2 + bj) << 2));
                        const float r = __builtin_amdgcn_rsqf(((p[0] + p[1]) + (p[2] + p[3])) * (1.0f / 128.0f) + 1e-6f); v0 = v0 * r * g0; v1 = v1 * r * g1; }
                    u32x4 w; w.x = cvt_pk_bf16(v0[0], v0[1]); w.y = cvt_pk_bf16(v0[2], v0[3]); w.z = cvt_pk_bf16(v1[0], v1[1]); w.w = cvt_pk_bf16(v1[2], v1[3]);
                    *(u32x4*)(rowp + bj * HALF) = w; } }
    }
};
__device__ __forceinline__ f32x4 silu_mul4(f32x4 g, f32x4 u, float nl, float r2) {
    f32x4 t = g * nl;
    t = (f32x4){__builtin_amdgcn_exp2f(t[0]), __builtin_amdgcn_exp2f(t[1]), __builtin_amdgcn_exp2f(t[2]), __builtin_amdgcn_exp2f(t[3])} + 1.0f;
    t = (f32x4){__builtin_amdgcn_rcpf(t[0]), __builtin_amdgcn_rcpf(t[1]), __builtin_amdgcn_rcpf(t[2]), __builtin_amdgcn_rcpf(t[3])} * r2;
    return (g * u) * t;
}
struct EpiSwiGLU {
    static constexpr bool PERM = true, AFTER_DRAIN = false;
    bf16_t* O; int ldc; const PG8_LAS float* rstab;
    __device__ __forceinline__ void operator()(const f32x4 (&acc)[2][2][4][2], const Unit& u, int wr, int wc, int fr, int fq) const {
        const int row0 = u.pm * BM + wr * 64 + fr, col0 = u.pn * HALF + wc * 32 + 8 * fq;
        float rs[2][4]; row_rstd(rs, rstab, u, wr, fr);
#pragma unroll
        for (int ai = 0; ai < 2; ++ai)
#pragma unroll
            for (int m = 0; m < 4; ++m) { bf16_t* rowp = O + (size_t)(row0 + ai * HALF + m * 16) * ldc + col0; const float r = rs[ai][m], nl = r * -1.4426950408889634f, r2 = r * r;
                const f32x4 g0 = acc[ai][0][m][0], g1 = acc[ai][0][m][1], u0 = acc[ai][1][m][0], u1 = acc[ai][1][m][1];
                const f32x4 h0 = silu_mul4(g0, u0, nl, r2), h1 = silu_mul4(g1, u1, nl, r2);
                u32x4 w; w.x = cvt_pk_bf16(h0[0], h0[1]); w.y = cvt_pk_bf16(h0[2], h0[3]); w.z = cvt_pk_bf16(h1[0], h1[1]); w.w = cvt_pk_bf16(h1[2], h1[3]);
                *(u32x4*)rowp = w; }
    }
};
template <bool FINAL>
struct EpiResid16 {
    static constexpr bool PERM = true, AFTER_DRAIN = false;
    bf16_t* x16; float* ss; float* outf; int ldc; float scale;
    __device__ __forceinline__ void operator()(const f32x4 (&acc)[2][2][4][2], const Unit& u, int wr, int wc, int fr, int fq) const {
        const int row0 = u.pm * BM + wr * 64 + fr, col0 = u.pn * BM + wc * 32 + 8 * fq;
        u32x4 b[2][4][2];
#pragma unroll
        for (int ai = 0; ai < 2; ++ai)
#pragma unroll
            for (int m = 0; m < 4; ++m)
#pragma unroll
                for (int bj = 0; bj < 2; ++bj) b[ai][m][bj] = *(const u32x4*)(x16 + (size_t)(row0 + ai * HALF + m * 16) * ldc + col0 + bj * HALF);
        asm volatile("" ::: "memory");
#pragma unroll
        for (int ai = 0; ai < 2; ++ai)
#pragma unroll
            for (int m = 0; m < 4; ++m) { const int row = row0 + ai * HALF + m * 16; const size_t off = (size_t)row * ldc + col0; float part = 0.f;
#pragma unroll
                for (int bj = 0; bj < 2; ++bj) { const u32x4 w0 = b[ai][m][bj];
                    f32x4 v0 = {__uint_as_float(w0.x << 16), __uint_as_float(w0.x & 0xffff0000u), __uint_as_float(w0.y << 16), __uint_as_float(w0.y & 0xffff0000u)};
                    f32x4 v1 = {__uint_as_float(w0.z << 16), __uint_as_float(w0.z & 0xffff0000u), __uint_as_float(w0.w << 16), __uint_as_float(w0.w & 0xffff0000u)};
                    v0 = v0 + acc[ai][bj][m][0] * scale; v1 = v1 + acc[ai][bj][m][1] * scale;
                    if (FINAL) { *(f32x4*)(outf + off + bj * HALF) = v0; *(f32x4*)(outf + off + bj * HALF + 4) = v1; }
                    else { u32x4 w; w.x = cvt_pk_bf16(v0[0], v0[1]); w.y = cvt_pk_bf16(v0[2], v0[3]); w.z = cvt_pk_bf16(v1[0], v1[1]); w.w = cvt_pk_bf16(v1[2], v1[3]);
                        *(u32x4*)(x16 + off + bj * HALF) = w;
                        const float r0 = __uint_as_float(w.x << 16), r1 = __uint_as_float(w.x & 0xffff0000u), r2 = __uint_as_float(w.y << 16), r3 = __uint_as_float(w.y & 0xffff0000u);
                        const float r4 = __uint_as_float(w.z << 16), r5 = __uint_as_float(w.z & 0xffff0000u), r6 = __uint_as_float(w.w << 16), r7 = __uint_as_float(w.w & 0xffff0000u);
                        part += ((r0 * r0 + r1 * r1) + (r2 * r2 + r3 * r3)) + ((r4 * r4 + r5 * r5) + (r6 * r6 + r7 * r7)); } }
                if (!FINAL) { part += shx(part, 16); part += shx(part, 32);
                    if (fq == 0) ss[(size_t)row * 32 + u.pn * 4 + wc] = part; } }
    }
};

template <class Epi, class Sched, bool ALIGN_EPI = false, bool SP2 = false>
__device__ __forceinline__ void gemm_phase(PG8_LAS unsigned char* lds, const Gemm g, const Sched& S, const Epi& E, int tid_in) {
    int tid_ = tid_in; asm volatile("" : "+v"(tid_));
    const int tid = tid_, wid = __builtin_amdgcn_readfirstlane(tid >> 6), lane = tid & 63, wr = wid >> 2, wc = wid & 3, fr = lane & 15, fq = lane >> 4;
    const int K = g.K, nt = K / BK;
    unsigned voffA[2], voffB[2];
#pragma unroll
    for (int i = 0; i < 2; ++i) { int R, C; stage_rc(tid * 16 + i * 8192, R, C); const int Rb = Epi::PERM ? ((R & ~31) + perm32(R & 31)) : R;
        voffA[i] = (unsigned)(R * K + C) * 2u; voffB[i] = (unsigned)(Rb * K + C) * 2u; }
    const size_t kstep = (size_t)(BK * 2);
    const size_t hstep = (size_t)HALF * K * 2;
    const size_t tstep = 2 * hstep;
    const unsigned ldsw = (unsigned)wid * 1024u;
    const int aoff = lds_byte(wr * 64 + fr, fq * 8), boff = lds_byte(wc * 32 + fr, fq * 8);
#define PG8_SA(b, h) (((b) * 2 + (h)) * HTB)
#define PG8_SB(b, h) ((4 + (b) * 2 + (h)) * HTB)
#define PG8_STAGE(bufoff, gbase, voff) do { _Pragma("unroll") for (int _i = 0; _i < 2; ++_i) \
        __builtin_amdgcn_global_load_lds((const unsigned*)((const char*)(gbase) + (voff)[_i]), (PG8_LAS unsigned*)(lds + (bufoff) + ldsw + _i * 8192), 16, 0, 0); } while (0)
#define PG8_LDA(dst, b, h) do { _Pragma("unroll") for (int m = 0; m < 4; ++m) _Pragma("unroll") for (int k = 0; k < 2; ++k) dst[m][k] = *(const PG8_LAS bf16x8*)(lds + PG8_SA(b, h) + aoff + m * 2048 + k * 1024); } while (0)
#define PG8_LDB(dst, b, h) do { _Pragma("unroll") for (int n = 0; n < 2; ++n) _Pragma("unroll") for (int k = 0; k < 2; ++k) dst[n][k] = *(const PG8_LAS bf16x8*)(lds + PG8_SB(b, h) + boff + n * 2048 + k * 1024); } while (0)
#define PG8_PRIO(x) __builtin_amdgcn_s_setprio(x)
#define PG8_MMA(ai, bj, At, Bt) do { PG8_PRIO(1); _Pragma("unroll") for (int m = 0; m < 4; ++m) _Pragma("unroll") for (int n = 0; n < 2; ++n) _Pragma("unroll") for (int k = 0; k < 2; ++k) \
        acc[ai][bj][m][n] = __builtin_amdgcn_mfma_f32_16x16x32_bf16(Bt[n][k], At[m][k], acc[ai][bj][m][n], 0, 0, 0); PG8_PRIO(0); } while (0)
#define PG8_WAIT_V(n) asm volatile("s_waitcnt vmcnt(" #n ")" ::: "memory")
#define PG8_WAIT_L(n) asm volatile("s_waitcnt lgkmcnt(" #n ")" ::: "memory")
#define PG8_BAR __builtin_amdgcn_s_barrier()
#define PG8_SCHED __builtin_amdgcn_sched_barrier(0)
    Unit cur, nxt; int ui = 0;
    if (!S.next(0, cur)) return;
    f32x4 acc[2][2][4][2];
#pragma unroll
    for (int a = 0; a < 2; ++a)
#pragma unroll
        for (int b = 0; b < 2; ++b)
#pragma unroll
            for (int m = 0; m < 4; ++m)
#pragma unroll
                for (int n = 0; n < 2; ++n) acc[a][b][m][n] = (f32x4){0.f, 0.f, 0.f, 0.f};
    bf16x8 At[4][2], B0[2][2], B1[2][2];
    const char* cA = (const char*)g.A + (size_t)cur.pm * tstep; const char* cB = (const char*)g.Bt + (size_t)cur.pn * tstep;
    S.a_ready(cur);
    if constexpr (SP2) {
        PG8_STAGE(PG8_SB(0, 0), cB, voffB); PG8_STAGE(PG8_SB(0, 1), cB + hstep, voffB); PG8_STAGE(PG8_SA(0, 0), cA, voffA); PG8_STAGE(PG8_SA(0, 1), cA + hstep, voffA);
        if (wr == 1) PG8_BAR;
        PG8_WAIT_V(2); PG8_BAR;
        PG8_STAGE(PG8_SB(1, 0), cB + kstep, voffB); PG8_STAGE(PG8_SA(1, 0), cA + kstep, voffA); PG8_STAGE(PG8_SB(1, 1), cB + hstep + kstep, voffB);
        PG8_WAIT_V(6); PG8_BAR;
    } else {
        PG8_STAGE(PG8_SB(0, 0), cB, voffB); PG8_STAGE(PG8_SA(0, 0), cA, voffA); PG8_STAGE(PG8_SB(0, 1), cB + hstep, voffB); PG8_STAGE(PG8_SA(0, 1), cA + hstep, voffA);
        if (wr == 1) PG8_BAR;
        PG8_WAIT_V(4); PG8_BAR;
        PG8_STAGE(PG8_SB(1, 0), cB + kstep, voffB); PG8_STAGE(PG8_SA(1, 0), cA + kstep, voffA); PG8_STAGE(PG8_SB(1, 1), cB + hstep + kstep, voffB);
        PG8_WAIT_V(6); PG8_BAR;
    }
    for (;;) {
        const bool has_next = S.next(ui + 1, nxt);
        const char* nA = has_next ? (const char*)g.A + (size_t)nxt.pm * tstep : cA; const char* nB = has_next ? (const char*)g.Bt + (size_t)nxt.pn * tstep : cB;
        for (int t = 0; t < nt; t += 2) {
            const bool last = (t == nt - 2);
            const char* a1 = cA + (size_t)(t + 1) * kstep;
            const char* a2 = last ? nA : cA + (size_t)(t + 2) * kstep; const char* b2 = last ? nB : cB + (size_t)(t + 2) * kstep;
            const char* a3 = a2 + kstep; const char* b3 = b2 + kstep;
            if (last && has_next) S.a_ready(nxt);
            if constexpr (SP2) {
            PG8_LDB(B0, 0, 0); PG8_LDB(B1, 0, 1); PG8_SCHED; PG8_LDA(At, 0, 0); PG8_STAGE(PG8_SA(1, 1), a1 + hstep, voffA);
            PG8_WAIT_V(8); PG8_WAIT_L(0); PG8_BAR; PG8_MMA(0, 0, At, B0); PG8_MMA(0, 1, At, B1); PG8_BAR; PG8_SCHED;
            PG8_LDA(At, 0, 1); PG8_STAGE(PG8_SB(0, 0), b2, voffB); PG8_STAGE(PG8_SB(0, 1), b2 + hstep, voffB); PG8_STAGE(PG8_SA(0, 0), a2, voffA);
            PG8_WAIT_V(8); PG8_WAIT_L(0); PG8_BAR; PG8_MMA(1, 0, At, B0); PG8_MMA(1, 1, At, B1); PG8_BAR; PG8_SCHED;
            PG8_LDB(B0, 1, 0); PG8_LDB(B1, 1, 1); PG8_SCHED; PG8_LDA(At, 1, 0); PG8_STAGE(PG8_SA(0, 1), a2 + hstep, voffA);
            PG8_WAIT_V(8); PG8_WAIT_L(0); PG8_BAR; PG8_MMA(0, 0, At, B0); PG8_MMA(0, 1, At, B1); PG8_BAR; PG8_SCHED;
            PG8_LDA(At, 1, 1); PG8_STAGE(PG8_SB(1, 0), b3, voffB); PG8_STAGE(PG8_SB(1, 1), b3 + hstep, voffB); PG8_STAGE(PG8_SA(1, 0), a3, voffA);
            PG8_WAIT_V(8); PG8_WAIT_L(0); PG8_BAR; PG8_MMA(1, 0, At, B0); PG8_MMA(1, 1, At, B1); PG8_BAR; PG8_SCHED;
            } else {
            PG8_LDB(B0, 0, 0); PG8_SCHED; PG8_LDA(At, 0, 0); PG8_STAGE(PG8_SA(1, 1), a1 + hstep, voffA);
            PG8_WAIT_L(8); PG8_BAR; PG8_WAIT_L(0); PG8_MMA(0, 0, At, B0); PG8_BAR; PG8_SCHED;
            PG8_LDB(B1, 0, 1); PG8_STAGE(PG8_SB(0, 0), b2, voffB);
            PG8_BAR; PG8_WAIT_L(0); PG8_MMA(0, 1, At, B1); PG8_BAR;
            PG8_LDA(At, 0, 1); PG8_STAGE(PG8_SA(0, 0), a2, voffA);
            PG8_BAR; PG8_WAIT_L(0); PG8_MMA(1, 0, At, B0); PG8_BAR; PG8_SCHED;
            PG8_STAGE(PG8_SB(0, 1), b2 + hstep, voffB);
            PG8_WAIT_V(6); PG8_BAR; PG8_MMA(1, 1, At, B1); PG8_BAR;
            PG8_LDB(B0, 1, 0); PG8_SCHED; PG8_LDA(At, 1, 0); PG8_STAGE(PG8_SA(0, 1), a2 + hstep, voffA);
            PG8_WAIT_L(8); PG8_BAR; PG8_WAIT_L(0); PG8_MMA(0, 0, At, B0); PG8_BAR; PG8_SCHED;
            PG8_LDB(B1, 1, 1); PG8_STAGE(PG8_SB(1, 0), b3, voffB);
            PG8_BAR; PG8_WAIT_L(0); PG8_MMA(0, 1, At, B1); PG8_BAR;
            PG8_LDA(At, 1, 1); PG8_STAGE(PG8_SA(1, 0), a3, voffA);
            PG8_BAR; PG8_WAIT_L(0); PG8_MMA(1, 0, At, B0); PG8_BAR; PG8_SCHED;
            PG8_STAGE(PG8_SB(1, 1), b3 + hstep, voffB);
            PG8_WAIT_V(6); PG8_BAR; PG8_MMA(1, 1, At, B1); PG8_BAR;
            }
        }
        if constexpr (ALIGN_EPI) { if (wr == 0) PG8_BAR; }
        if constexpr (!Epi::AFTER_DRAIN) { E(acc, cur, wr, wc, fr, fq); S.done(cur); }
        if (!has_next) break;
#pragma unroll
        for (int a = 0; a < 2; ++a)
#pragma unroll
            for (int b = 0; b < 2; ++b)
#pragma unroll
                for (int m = 0; m < 4; ++m)
#pragma unroll
                    for (int n = 0; n < 2; ++n) { double z0_, z1_; asm volatile("v_mov_b64 %0, 0\n\tv_mov_b64 %1, 0" : "=v"(z0_), "=v"(z1_)); typedef double f64x2_ __attribute__((ext_vector_type(2))); acc[a][b][m][n] = __builtin_bit_cast(f32x4, (f64x2_){z0_, z1_}); }
        cur = nxt; cA = nA; cB = nB; ++ui;
        if constexpr (ALIGN_EPI) { if (wr == 1) PG8_BAR; }
    }
    PG8_WAIT_V(0);
    if constexpr (!ALIGN_EPI) { if (wr == 0) PG8_BAR; }
    PG8_BAR;
    if constexpr (Epi::AFTER_DRAIN) { E.fused(acc, cur, wr, wc, fr, fq, lds, wid, lane); S.done(cur); }
#undef PG8_SA
#undef PG8_SB
#undef PG8_STAGE
#undef PG8_LDA
#undef PG8_LDB
#undef PG8_MMA
#undef PG8_WAIT_V
#undef PG8_WAIT_L
#undef PG8_BAR
#undef PG8_SCHED
}
}

constexpr int NWAVES = 8;
constexpr int BATCH = 2, SEQ = 8192, DM = 2048, DFF = 5504, HD = 128;
constexpr int M = BATCH * SEQ;
constexpr int NQKV = 3 * DM, NKV = 2 * DM, NWI = 2 * DFF;
constexpr float EPS = 1e-6f;
constexpr float ATT_SCALE = 0.08838834764831845f;

constexpr size_t MiB = 1u << 20;
constexpr size_t WS_CTL = 0, CTL_ZERO_BYTES = 1 * MiB;
constexpr size_t SZ_WI = (size_t)NWI * DM * 2, SZ_WO = (size_t)DM * DFF * 2;
constexpr size_t WS_WI_PRE = 2 * MiB, WS_WI_POST = WS_WI_PRE + 4 * SZ_WI, WS_WO_PRE = WS_WI_POST + 4 * SZ_WI, WS_WO_POST = WS_WO_PRE + 4 * SZ_WO;
constexpr size_t WS_AWQKV = WS_WO_POST + 4 * SZ_WO, SZ_AWQKV = (size_t)NQKV * DM * 2;
constexpr size_t WS_AWO = WS_AWQKV + 2 * SZ_AWQKV, SZ_DD = (size_t)DM * DM * 2;
constexpr size_t WS_BWKV = WS_AWO + 2 * SZ_DD, WS_BWQ = WS_BWKV + 2 * SZ_DD, WS_BWO = WS_BWQ + 2 * SZ_DD;
constexpr size_t WS_LUT = WS_BWO + 2 * SZ_DD;
constexpr size_t WS_XN = WS_LUT + 1 * MiB, SZ_MD = (size_t)M * DM * 2;
constexpr size_t WS_OB = WS_XN + SZ_MD;
constexpr size_t WS_H = WS_OB + SZ_MD, SZ_H = (size_t)M * DFF * 2;
constexpr size_t WS_QKV = WS_H + SZ_H, SZ_QKV = (size_t)M * NQKV * 2;
constexpr size_t WS_KVSH = WS_QKV + SZ_QKV, SZ_KVSH = (size_t)M * NKV * 2;
constexpr size_t WS_SS = WS_KVSH + SZ_KVSH, SZ_SS = (size_t)M * 32 * 4;
constexpr size_t WS_END = WS_SS + 13 * SZ_SS;
constexpr int CW_TMO = 0, CW_CODE = 1;
constexpr int CW_BAR = 4096;
constexpr int RING_OFF = 0, RING_BYTES = 131072;
constexpr int LDSCTL_OFF = RING_BYTES, MISC_OFF = LDSCTL_OFF + 320;
constexpr int QKG_OFF = LDSCTL_OFF + 512, QKX_OFF = QKG_OFF + 1024;
constexpr int RSTD_OFF = QKX_OFF + 8192;
constexpr int LDS_BYTES = 155648;
static_assert(MISC_OFF + 128 <= QKG_OFF && RSTD_OFF + 11 * 1024 <= LDS_BYTES && LDS_BYTES <= 163840, "LDS map");

#define GAS __attribute__((address_space(1)))
#define LAS __attribute__((address_space(3)))
typedef unsigned short bf16;
typedef unsigned v4u __attribute__((ext_vector_type(4)));
typedef float f32x4 __attribute__((ext_vector_type(4)));
typedef short bf16x8 __attribute__((ext_vector_type(8)));
typedef GAS unsigned gu32;
typedef GAS unsigned long long gu64;
#define RLX_AGENT __ATOMIC_RELAXED, __HIP_MEMORY_SCOPE_AGENT
#define LDS_WAIT() asm volatile("s_waitcnt lgkmcnt(0)" ::: "memory")
#define VM_WAIT() asm volatile("s_waitcnt vmcnt(0)" ::: "memory")
__device__ __forceinline__ unsigned long long rt() { return __builtin_amdgcn_s_memrealtime(); }
__device__ __forceinline__ unsigned f2bf(float f) { unsigned u = __builtin_bit_cast(unsigned, f); return (u + 0x7fffu + ((u >> 16) & 1u)) >> 16; }
__device__ __forceinline__ unsigned pk2(float lo, float hi) { return f2bf(lo) | (f2bf(hi) << 16); }

#define XB_TMO      128
#define XB_XCNT(j)  (256  + 64 * (j))
#define XB_XSUB(j)  (1280 + 64 * (j))
#define XB_XGEN(j)  (2304 + 64 * (j))
#define XB_TOP      3328
#define XB_TOPGEN   3392
#define XCD_BAR_WORDS 3456
#define XB_SPIN_CAP (1u << 18)

__device__ __forceinline__ unsigned xb_ld(unsigned* p)              { return __hip_atomic_load(p, __ATOMIC_RELAXED, __HIP_MEMORY_SCOPE_AGENT); }
__device__ __forceinline__ unsigned xb_add(unsigned* p, unsigned v) { return __hip_atomic_fetch_add(p, v, __ATOMIC_RELAXED, __HIP_MEMORY_SCOPE_AGENT); }
__device__ __forceinline__ unsigned xb_xcc_id() { return (unsigned)__builtin_amdgcn_s_getreg((3 << 11) | 20) & 0xFu; }
#define XB_SPIN(cond, bar) do { unsigned _sp = 0; while (cond) { __builtin_amdgcn_s_sleep(1); \
    if ((++_sp & 255u) == 0u) { if (xb_ld(&(bar)[XB_TMO])) break; if (_sp > XB_SPIN_CAP) { atomicAdd(&(bar)[XB_TMO], 1u); break; } } } } while (0)

struct XcdBarrier {
    unsigned* bar; unsigned x; int tid;
    volatile LAS unsigned* st;
};

__device__ __forceinline__ XcdBarrier xcd_barrier_post(unsigned* bar, volatile LAS unsigned* st) {
    XcdBarrier b; b.bar = bar; b.x = xb_xcc_id(); b.st = st; b.tid = (int)threadIdx.x;
    if (threadIdx.x == 0) (void)xb_add(&bar[XB_XCNT(b.x)], 1u);
    return b;
}
__device__ __forceinline__ void xcd_barrier_complete(unsigned* bar, unsigned x, unsigned& nloc, unsigned& nx) {
    const unsigned G = gridDim.x * gridDim.y * gridDim.z;
    unsigned sum, cnt, mine, sp = 0u;
    for (;;) {
        sum = 0u; cnt = 0u; mine = 0u;
#pragma unroll
        for (unsigned j = 0; j < 16; ++j) { const unsigned c = xb_ld(&bar[XB_XCNT(j)]); sum += c; cnt += (c > 0u) ? 1u : 0u; mine = (j == x) ? c : mine; }
        if (sum == G) break;
        __builtin_amdgcn_s_sleep(1);
        if ((++sp & 255u) == 0u) { if (xb_ld(&bar[XB_TMO])) break; if (sp > XB_SPIN_CAP) { atomicAdd(&bar[XB_TMO], 1u); break; } }
    }
    nloc = mine > 0u ? mine : 1u; nx = cnt > 0u ? cnt : 1u;
}

__device__ __forceinline__ void xcd_barrier(const XcdBarrier& b) {
    asm volatile("s_waitcnt vmcnt(0)" ::: "memory");
    __syncthreads();
    int tid0_ = b.tid; asm volatile("" : "+v"(tid0_));
    if (tid0_ == 0) {
        unsigned* bar = b.bar;
        __builtin_amdgcn_s_waitcnt(0);
        unsigned nloc = b.st[0], nx = b.st[1];
        if (nloc == 0u) { xcd_barrier_complete(bar, b.x, nloc, nx); b.st[0] = nloc; b.st[1] = nx; }
        const unsigned old = xb_add(&bar[XB_XSUB(b.x)], 1u);
        const unsigned gen = old / nloc;
        if (old + 1u == (gen + 1u) * nloc) {
            __builtin_amdgcn_fence(__ATOMIC_RELEASE, "agent");
            asm volatile("s_waitcnt vmcnt(0)" ::: "memory");
            const unsigned og = xb_add(&bar[XB_TOP], 1u);
            const unsigned tg = og / nx;
            if (og + 1u == (tg + 1u) * nx) xb_add(&bar[XB_TOPGEN], 1u);
            else XB_SPIN(xb_ld(&bar[XB_TOPGEN]) == tg, bar);
            __builtin_amdgcn_fence(__ATOMIC_ACQUIRE, "agent");
            xb_add(&bar[XB_XGEN(b.x)], 1u);
            asm volatile("s_waitcnt vmcnt(0)" ::: "memory");
        } else {
            XB_SPIN(xb_ld(&bar[XB_XGEN(b.x)]) == gen, bar);
            __builtin_amdgcn_fence(__ATOMIC_ACQUIRE, "agent");
            asm volatile("s_waitcnt vmcnt(0)" ::: "memory");
        }
    }
    __syncthreads();
}

struct Args { const float* in[19]; float* out; unsigned char* ws; };
__device__ __forceinline__ int launder_v(int v) { asm volatile("" : "+v"(v)); return v; }
#define CUR_TID(F) (((F).wave << 6) | lane_id())
struct Frame {
    LAS unsigned char* lds;
    volatile LAS unsigned* MISC;
    gu32* ctl;
    int wave;
    int vcu, G;
};
__device__ __forceinline__ float wave_sum(float v) {
#pragma unroll
    for (int o = 1; o < 64; o <<= 1) v += shx(v, o);
    return v;
}
__device__ __forceinline__ float wave_max(float v) {
#pragma unroll
    for (int o = 1; o < 64; o <<= 1) v = fmaxf(v, shx(v, o));
    return v;
}
__device__ __forceinline__ float bf2f(unsigned short h) { return __uint_as_float((unsigned)h << 16); }
__device__ __forceinline__ float bflo(unsigned w) { return __uint_as_float(w << 16); }
__device__ __forceinline__ float bfhi(unsigned w) { return __uint_as_float(w & 0xffff0000u); }

__device__ __forceinline__ int t5_bucket(int n) {
    if (n < 16) return n;
    if (n >= 113) return 31;
    int b = 16;
    b += (n >= 19); b += (n >= 21); b += (n >= 24); b += (n >= 27); b += (n >= 31); b += (n >= 35); b += (n >= 40); b += (n >= 46);
    b += (n >= 52); b += (n >= 59); b += (n >= 67); b += (n >= 77); b += (n >= 87); b += (n >= 99);
    return b;
}

template <bool GLU>
__device__ __forceinline__ void transpose_group(Frame& F, int part, int nparts, const float* W, const float* gain, int L, int K, int N, bf16* WT, LAS float* scr, float wscale = 1.0f) {
    int gw = part * NWAVES + F.wave; asm volatile("" : "+s"(gw)); const int NGW = nparts * NWAVES; const int lane = lane_id();
    const int nblk = N / 32, kblk = K / 64, per = nblk * kblk, total = L * per;
    const int c = lane & 7, lr = lane >> 3;
    f32x4 v[8], g0 = {1.f, 1.f, 1.f, 1.f}, g1 = g0;
#define TG_DECODE(it_) const int l_ = (it_) / per, r_ = (it_) - l_ * per, kb_ = r_ / nblk, nb_ = r_ - kb_ * nblk, n0_ = nb_ * 32, k0_ = kb_ * 64; const size_t lo_ = (size_t)l_ * K * N;
#define TG_LOAD(it_) do { TG_DECODE(it_); const float* w_ = W + lo_ + (size_t)(k0_ + lr) * N + n0_ + 4 * c;                                                   \
        _Pragma("unroll") for (int i = 0; i < 8; ++i) v[i] = *(const GAS f32x4*)(w_ + (size_t)(8 * i) * N);                                                    \
        if (gain) { const float* g_ = gain + (size_t)l_ * K + k0_ + 8 * c; g0 = *(const GAS f32x4*)g_; g1 = *(const GAS f32x4*)(g_ + 4); } } while (0)
    if (gw < total) TG_LOAD(gw);
    for (int it = gw; it < total; it += NGW) {
#pragma unroll
        for (int i = 0; i < 8; ++i) { LAS float* d = scr + (8 * i + lr) * 33 + 4 * c; d[0] = v[i].x; d[1] = v[i].y; d[2] = v[i].z; d[3] = v[i].w; }
        const f32x4 h0 = g0 * wscale, h1 = g1 * wscale;
        LDS_WAIT(); asm volatile("" ::: "memory");
        if (it + NGW < total) TG_LOAD(it + NGW);
        TG_DECODE(it);
        int drow0 = n0_;
        if (GLU) { const int half = N / 2; const int cc = n0_ >= half ? n0_ - half : n0_; drow0 = (cc >> 7) * 256 + (n0_ >= half ? 128 : 0) + (cc & 127); }
        bf16* wt_ = WT + lo_ + (size_t)drow0 * K + k0_ + 8 * c;
#pragma unroll
        for (int j = 0; j < 4; ++j) { const int n = lr + 8 * j; const LAS float* s = scr + (8 * c) * 33 + n;
            v4u o; o.x = pg8::cvt_pk_bf16(s[0 * 33] * h0.x, s[1 * 33] * h0.y); o.y = pg8::cvt_pk_bf16(s[2 * 33] * h0.z, s[3 * 33] * h0.w); o.z = pg8::cvt_pk_bf16(s[4 * 33] * h1.x, s[5 * 33] * h1.y); o.w = pg8::cvt_pk_bf16(s[6 * 33] * h1.z, s[7 * 33] * h1.w);
            *(GAS v4u*)(wt_ + (size_t)n * K) = o; }
        LDS_WAIT(); asm volatile("" ::: "memory");
    }
#undef TG_LOAD
#undef TG_DECODE
}
__device__ __forceinline__ void cast_rows(Frame& F, const float* x, bf16* xb, float* ss) {
    int gw = F.vcu * NWAVES + F.wave; asm volatile("" : "+s"(gw)); const int NGW = F.G * NWAVES; const int lane = lane_id();
    for (int m = gw; m < M; m += NGW) {
        const GAS f32x4* xr = (const GAS f32x4*)(x + (size_t)m * DM) + lane;
        f32x4 v[8]; float s = 0.f;
#pragma unroll
        for (int j = 0; j < 8; ++j) { v[j] = xr[64 * j]; s += (v[j].x * v[j].x + v[j].y * v[j].y) + (v[j].z * v[j].z + v[j].w * v[j].w); }
        s = wave_sum(s);
        GAS unsigned long long* o8 = (GAS unsigned long long*)(xb + (size_t)m * DM) + lane;
#pragma unroll
        for (int j = 0; j < 8; ++j) o8[64 * j] = (unsigned long long)pk2(v[j].x, v[j].y) | ((unsigned long long)pk2(v[j].z, v[j].w) << 32);
        if (lane < 32) ss[(size_t)m * 32 + lane] = lane == 0 ? s : 0.f;
    }
}
namespace att {
typedef short s16x4 __attribute__((ext_vector_type(4)));
typedef float f32x16 __attribute__((ext_vector_type(16)));
typedef unsigned u32x4 __attribute__((ext_vector_type(4)));
constexpr int NW = 8, QBLK = 32, KVBLK = 64, QB = NW * QBLK, D = 128;
constexpr int SHM_V = KVBLK * D * 2, SHM_K = KVBLK * D * 2;
constexpr int LDS_WS = 2 * SHM_V + 2 * SHM_K;
constexpr float SCALE = 0.08838834764831845f;
#define KSWZ(row, colB) ((row) * 256 + ((colB) ^ (((row) & 7) << 4)))
#define SBAR() __builtin_amdgcn_sched_barrier(0)
__device__ __forceinline__ int v_st(int k, int c) { const int kk = (k & ~0xC) | ((k & 4) << 1) | ((k & 8) >> 1); return ((kk >> 3) * 4 + (c >> 5)) * 512 + ((kk & 7) * 32 + (c & 31)) * 2; }
__device__ __forceinline__ int v_rd_base(int lane) { return ((lane & 3) << 3) | (((lane >> 2) & 3) << 6) | (((lane >> 4) & 1) << 5) | (((lane >> 5) & 1) << 8); }
constexpr int v_rd_off(int d0, int ks, int half) { return d0 * 512 + ks * 4096 + half * 2048; }
__device__ __forceinline__ int crow(int r, int hi) { return (r & 3) + 8 * (r >> 2) + 4 * hi; }
__device__ __forceinline__ unsigned cvtpk(float lo, float hi) { unsigned r; asm volatile("v_cvt_pk_bf16_f32 %0, %1, %2" : "=v"(r) : "v"(lo), "v"(hi)); return r; }
__device__ __forceinline__ bf16x8 load8(const bf16* p) { return *reinterpret_cast<const bf16x8*>(p); }

#define PK4(P, B_, OUT) do { unsigned a0 = cvtpk(P[B_+0], P[B_+1]), a1 = cvtpk(P[B_+2], P[B_+3]);                          \
        unsigned b0 = cvtpk(P[B_+4], P[B_+5]), b1 = cvtpk(P[B_+6], P[B_+7]);                                             \
        auto r0 = __builtin_amdgcn_permlane32_swap(a0, b0, false, false); auto r1 = __builtin_amdgcn_permlane32_swap(a1, b1, false, false); \
        u32x4 w = {r0[0], r1[0], r0[1], r1[1]}; OUT = *reinterpret_cast<bf16x8*>(&w); } while (0)
template <int KB>
__device__ __forceinline__ void qkt(f32x16& p0, f32x16& p1, const char* K_lds, int r32, int hi, const bf16x8* qr) {
    p0 = f32x16{}; p1 = f32x16{};
    const char* kb[4];
#pragma unroll
    for (int dd = 0; dd < 4; ++dd) kb[dd] = K_lds + KB * SHM_K + KSWZ(r32, (dd * 16 + hi * 8) * 2);
#pragma unroll
    for (int d0 = 0; d0 < 8; ++d0) { const char* a = kb[d0 & 3] + (d0 >> 2) * 128;
        bf16x8 b0 = *reinterpret_cast<const bf16x8*>(a);
        bf16x8 b1 = *reinterpret_cast<const bf16x8*>(a + 32 * 256);
        p0 = __builtin_amdgcn_mfma_f32_32x32x16_bf16(b0, qr[d0], p0, 0, 0, 0);
        p1 = __builtin_amdgcn_mfma_f32_32x32x16_bf16(b1, qr[d0], p1, 0, 0, 0); }
}
template <int VB>
__device__ __forceinline__ void pv_tile(f32x16* o, int vb0, bf16x8 pa0, bf16x8 pa1, bf16x8 pa2, bf16x8 pa3) {
#define TRRD(dst, off) asm volatile("ds_read_b64_tr_b16 %0, %1 offset:%2" : "=&v"(dst) : "v"(vb0), "i"(off) : "memory")
#define PV_D0(d0) do { s16x4 l0, l1, l2, l3, h0, h1, h2, h3; constexpr int b_ = VB * SHM_V + v_rd_off(d0, 0, 0);   \
        TRRD(l0, b_); TRRD(h0, b_ + 2048); TRRD(l1, b_ + 4096); TRRD(h1, b_ + 6144); TRRD(l2, b_ + 8192); TRRD(h2, b_ + 10240); TRRD(l3, b_ + 12288); TRRD(h3, b_ + 14336); \
        asm volatile("s_waitcnt lgkmcnt(0)" ::: "memory"); SBAR();   \
        o[d0] = __builtin_amdgcn_mfma_f32_32x32x16_bf16(pa0, (bf16x8){l0[0], l0[1], l0[2], l0[3], h0[0], h0[1], h0[2], h0[3]}, o[d0], 0, 0, 0);   \
        o[d0] = __builtin_amdgcn_mfma_f32_32x32x16_bf16(pa1, (bf16x8){l1[0], l1[1], l1[2], l1[3], h1[0], h1[1], h1[2], h1[3]}, o[d0], 0, 0, 0);   \
        o[d0] = __builtin_amdgcn_mfma_f32_32x32x16_bf16(pa2, (bf16x8){l2[0], l2[1], l2[2], l2[3], h2[0], h2[1], h2[2], h2[3]}, o[d0], 0, 0, 0);   \
        o[d0] = __builtin_amdgcn_mfma_f32_32x32x16_bf16(pa3, (bf16x8){l3[0], l3[1], l3[2], l3[3], h3[0], h3[1], h3[2], h3[3]}, o[d0], 0, 0, 0); } while (0)
    PV_D0(0); PV_D0(1); PV_D0(2); PV_D0(3);
#undef PV_D0
#undef TRRD
}

struct BlockRef { const bf16* Q; const bf16* K; const bf16* V; bf16* O; int P0; };
struct Seam { bf16x8 qr[8]; bf16x8 st_v0, st_v1, st_k0, st_k1; };
#define LD16(base, boff) (*(const bf16x8*)((const char*)(base) + (size_t)(boff) + loff))
#define VMW() asm volatile("s_waitcnt vmcnt(0)" ::: "memory")
#define SLOAD_H(Kp, Vp, k0) do { const size_t ko_ = (size_t)(k0) * KS * 2; S.st_v0 = LD16(Vp, ko_); S.st_v1 = LD16(Vp, ko_ + 32 * VS * 2);              \
                         S.st_k0 = LD16(Kp, ko_); S.st_k1 = LD16(Kp, ko_ + 32 * KS * 2); } while (0)
#define SWRITE_HK(bf) do { *(bf16x8*)(K_lds + (bf) * SHM_K + kws) = S.st_k0; *(bf16x8*)(K_lds + (bf) * SHM_K + kws + 32 * 256) = S.st_k1; } while (0)
#define SWRITE_HV(bf) do { *(bf16x8*)(V_lds + (bf) * SHM_V + vst0) = S.st_v0; *(bf16x8*)(V_lds + (bf) * SHM_V + vst1) = S.st_v1; } while (0)
#define SWRITE_H(bf) do { SWRITE_HV(bf); SWRITE_HK(bf); } while (0)

__device__ __forceinline__ void sb_weights(f32x16& p0, f32x16& p1, int dq, bool need_mask, int hi, float& C, bf16x8& pa0, bf16x8& pa1, bf16x8& pa2, bf16x8& pa3) {
    float qs[8], osi[9];
#pragma unroll
    for (int g = 0; g < 8; ++g) {
        float lk[4], y[4];
#pragma unroll
        for (int i = 0; i < 4; ++i) {
            y[i] = g < 4 ? p0[4 * g + i] : p1[4 * (g - 4) + i];
            const float sp = fmaxf(y[i], 0.f) + __builtin_amdgcn_logf(1.0f + __builtin_amdgcn_exp2f(-fabsf(y[i])));
            const int c = i + 8 * g;
            const bool valid = !need_mask || (dq - c > 0);
            lk[i] = valid ? -sp : 0.f;
            y[i] = valid ? y[i] : -__builtin_inff();
        }
        const float s2 = lk[3], s1 = s2 + lk[2], s0 = s1 + lk[1];
        qs[g] = s0 + lk[0];
        const float e0 = y[0] + lk[0] + s0, e1 = y[1] + lk[1] + s1, e2 = y[2] + lk[2] + s2, e3 = y[3] + lk[3];
        if (g < 4) { p0[4 * g] = e0; p0[4 * g + 1] = e1; p0[4 * g + 2] = e2; p0[4 * g + 3] = e3; }
        else { p1[4 * (g - 4)] = e0; p1[4 * (g - 4) + 1] = e1; p1[4 * (g - 4) + 2] = e2; p1[4 * (g - 4) + 3] = e3; }
    }
    osi[8] = 0.f;
#pragma unroll
    for (int g = 7; g >= 0; --g) osi[g] = qs[g] + osi[g + 1];
    float tot;
    { auto rr = __builtin_amdgcn_permlane32_swap(__float_as_uint(osi[0]), __float_as_uint(osi[0]), false, false); tot = __uint_as_float(rr[0]) + __uint_as_float(rr[1]); }
#pragma unroll
    for (int g = 0; g < 8; ++g) {
        auto rr = __builtin_amdgcn_permlane32_swap(__float_as_uint(osi[g]), __float_as_uint(osi[g + 1]), false, false);
        const float T = osi[g + 1] + (hi ? __uint_as_float(rr[0]) : __uint_as_float(rr[1])) + C;
#pragma unroll
        for (int i = 0; i < 4; ++i) {
            if (g < 4) p0[4 * g + i] = __builtin_amdgcn_exp2f(p0[4 * g + i] + T); else p1[4 * (g - 4) + i] = __builtin_amdgcn_exp2f(p1[4 * (g - 4) + i] + T);
        }
    }
    C += tot;
    PK4(p0, 0, pa0); PK4(p0, 8, pa1); PK4(p1, 0, pa2); PK4(p1, 8, pa3);
}
template <int QS, int KS, int VS, int OS, bool EXIT>
__device__ __forceinline__ void sb_block(const BlockRef& cur, char* lds, int tid) {
    static_assert(KS == VS, "one lane offset serves K and V");
    const int wid = __builtin_amdgcn_readfirstlane(tid >> 6), lane = tid & 63, r32 = lane & 31, hi = lane >> 5;
    const int NT = cur.P0 / KVBLK + 4;
    const int qlo = cur.P0 + wid * QBLK, qm = qlo + r32 - 4 * hi;
    char* V_lds = lds; char* K_lds = lds + 2 * SHM_V;
    volatile LAS unsigned* flags = (volatile LAS unsigned*)(uintptr_t)((unsigned)(uintptr_t)lds + LDS_WS);
    const int sr = tid >> 4, sc = (tid & 15) * 8, vst0 = v_st(sr, sc), vst1 = v_st(32 + sr, sc), kws = KSWZ(sr, sc * 2);
    const unsigned loff = (unsigned)(sr * KS + sc) * 2u, qoff = (unsigned)(r32 * QS + hi * 8) * 2u;
    const int vb0 = (int)(uintptr_t)V_lds + v_rd_base(lane);
    Seam S;
#pragma unroll
    for (int d0 = 0; d0 < 8; ++d0) S.qr[d0] = *(const bf16x8*)((const char*)cur.Q + (size_t)(wid * QBLK) * QS * 2 + d0 * 32 + qoff);
#define KBASE(t) ((NT - 1 - (t)) * KVBLK)
    SLOAD_H(cur.K, cur.V, KBASE(0)); VMW(); SWRITE_H(0);
    SLOAD_H(cur.K, cur.V, KBASE(1));
    __syncthreads();
    f32x16 o[4] = {}; float C = 0.f; f32x16 p0, p1; bf16x8 pa0, pa1, pa2, pa3;
    bool wdone = false;
#define SB_STEP(t, B) do {                                                                                       \
        { const int kb_ = KBASE(t);                                                                               \
          if (!wdone && kb_ < qlo + QBLK) {                  \
            SBAR(); qkt<B>(p0, p1, K_lds, r32, hi, S.qr);                                                          \
            sb_weights(p0, p1, qm - kb_, kb_ + KVBLK > qlo, hi, C, pa0, pa1, pa2, pa3);                            \
            SBAR(); pv_tile<B>(o, vb0, pa0, pa1, pa2, pa3);                                                        \
            if (EXIT) wdone = __all(C < -160.f); } }                                                              \
        if (EXIT) { if (lane == 0) flags[((t) & 1) * 8 + wid] = wdone ? 1u : 0u; }                                 \
        if ((t) + 1 < NT) { VMW(); SWRITE_H((B) ^ 1); if ((t) + 2 < NT) SLOAD_H(cur.K, cur.V, KBASE((t) + 2)); }  \
        __syncthreads(); } while (0)
    for (int t = 0; t < NT; t += 2) {
        SB_STEP(t, 0);
        SB_STEP(t + 1, 1);
        if (EXIT) { unsigned a = 1u;
#pragma unroll
            for (int w = 0; w < 8; ++w) a &= flags[8 + w];
            if (a) break; }
    }
    VMW();
    char* Ow = (char*)cur.O + (size_t)(wid * QBLK) * OS * 2; const unsigned ooff = (unsigned)(4 * hi * OS + r32) * 2u;
#pragma unroll
    for (int r = 0; r < 16; ++r) { const int orow0 = (r & 3) + 8 * (r >> 2);
#pragma unroll
        for (int d0 = 0; d0 < 4; ++d0) { const float v = o[d0][r];
            const float vn = shx(v, 1);
            if ((r32 & 1) == 0) *(unsigned*)(Ow + (size_t)(orow0 * OS + d0 * 32) * 2 + ooff) = cvtpk(v, vn); } }
    __syncthreads();
#undef KBASE
#undef SB_STEP
}
}
namespace att2 {
using att::f32x16; using att::s16x4; using att::u32x4; using att::cvtpk; using att::crow;
constexpr int STG = 32768, K2_OFF = 8192, V_OFF = 16384;
constexpr int LDS_WS = 131072 + 512, LDS_LUT = LDS_WS + 2048, LDS_END = LDS_LUT + 2 * 272 * 4;
constexpr float SCALE = att::SCALE, C2 = 1.4426950408889634f * SCALE;
#define SBAR() __builtin_amdgcn_sched_barrier(0)
#define A2_WAITV(n) asm volatile("s_waitcnt vmcnt(" #n ")" ::: "memory")
#define A2_BAR() do { asm volatile("s_waitcnt lgkmcnt(0)" ::: "memory"); __builtin_amdgcn_s_barrier(); asm volatile("" ::: "memory"); } while (0)
__device__ __forceinline__ void bias_mask16(f32x16& p, int dq, const LAS float* lut) {
    const float NEG = -__builtin_inff();
    const LAS float* lp = lut + 64 + dq;
    float bv[16];
#pragma unroll
    for (int r = 0; r < 16; ++r) { const int c = (r & 3) + 8 * (r >> 2); bv[r] = lp[-c]; }
#pragma unroll
    for (int r = 0; r < 16; ++r) { const int c = (r & 3) + 8 * (r >> 2); p[r] = (dq - c >= 0) ? p[r] + bv[r] : NEG; }
}
__device__ __forceinline__ void partialSM16(f32x16& p, float& m_reg, float& alpha, float bo) {
    constexpr float THR = 8.f;
    float pmax = p[0];
#pragma unroll
    for (int r = 1; r < 16; ++r) pmax = fmaxf(pmax, p[r]);
    { auto rr = __builtin_amdgcn_permlane32_swap(__float_as_uint(pmax), __float_as_uint(pmax), false, false); pmax = fmaxf(__uint_as_float(rr[0]), __uint_as_float(rr[1])); }
    pmax += bo;
    float mn;
    if (__builtin_expect(__all((pmax - m_reg) * SCALE <= THR), 1)) { mn = m_reg; alpha = 1.f; }
    else { mn = fmaxf(m_reg, pmax); alpha = __builtin_amdgcn_exp2f((m_reg - mn) * C2); m_reg = mn; }
    const float mnL = (bo - mn) * C2;
#pragma unroll
    for (int r = 0; r < 16; ++r) p[r] = fmaf(p[r], C2, mnL);
}
__device__ __forceinline__ void finishSM16(f32x16& p, float alpha, float& l_reg, bf16x8& pa0, bf16x8& pa1) {
#pragma unroll
    for (int r = 0; r < 16; ++r) p[r] = __builtin_amdgcn_exp2f(p[r]);
    float ps = 0.f;
#pragma unroll
    for (int r = 0; r < 16; ++r) ps += p[r];
    { auto rr = __builtin_amdgcn_permlane32_swap(__float_as_uint(ps), __float_as_uint(ps), false, false); ps = __uint_as_float(rr[0]) + __uint_as_float(rr[1]); }
    l_reg = l_reg * alpha + ps;
    PK4(p, 0, pa0); PK4(p, 8, pa1);
}
#define KRD(dst, addr, off) asm volatile("ds_read_b128 %0, %1 offset:%2" : "=&v"(dst) : "v"(addr), "i"(off) : "memory")
#define KWAIT(n, dst) asm volatile("s_waitcnt lgkmcnt(" #n ")" : "+v"(dst) :: "memory")
__device__ __forceinline__ void qkt16_exp(f32x16& px, f32x16& py, int kb, const int (&kofs)[4], const bf16x8* qr) {
    bf16x8 k0, k1;
    KRD(k0, kb + kofs[0], 0); KRD(k1, kb + kofs[1], 0);
    px = f32x16{};
#define EX2(i) do { py[2 * (i)] = __builtin_amdgcn_exp2f(py[2 * (i)]); py[2 * (i) + 1] = __builtin_amdgcn_exp2f(py[2 * (i) + 1]); } while (0)
    KWAIT(1, k0); px = __builtin_amdgcn_mfma_f32_32x32x16_bf16(k0, qr[0], px, 0, 0, 0); KRD(k0, kb + kofs[2], 0);   EX2(0); SBAR();
    KWAIT(1, k1); px = __builtin_amdgcn_mfma_f32_32x32x16_bf16(k1, qr[1], px, 0, 0, 0); KRD(k1, kb + kofs[3], 0);   EX2(1); SBAR();
    KWAIT(1, k0); px = __builtin_amdgcn_mfma_f32_32x32x16_bf16(k0, qr[2], px, 0, 0, 0); KRD(k0, kb + kofs[0], 128); EX2(2); SBAR();
    KWAIT(1, k1); px = __builtin_amdgcn_mfma_f32_32x32x16_bf16(k1, qr[3], px, 0, 0, 0); KRD(k1, kb + kofs[1], 128); EX2(3); SBAR();
    KWAIT(1, k0); px = __builtin_amdgcn_mfma_f32_32x32x16_bf16(k0, qr[4], px, 0, 0, 0); KRD(k0, kb + kofs[2], 128); EX2(4); SBAR();
    KWAIT(1, k1); px = __builtin_amdgcn_mfma_f32_32x32x16_bf16(k1, qr[5], px, 0, 0, 0); KRD(k1, kb + kofs[3], 128); EX2(5); SBAR();
    KWAIT(1, k0); px = __builtin_amdgcn_mfma_f32_32x32x16_bf16(k0, qr[6], px, 0, 0, 0); EX2(6); SBAR();
    KWAIT(0, k1); px = __builtin_amdgcn_mfma_f32_32x32x16_bf16(k1, qr[7], px, 0, 0, 0); EX2(7); SBAR();
#undef EX2
}
__device__ __forceinline__ void finish_pack16(f32x16& p, float alpha, float& l_reg, bf16x8& pa0, bf16x8& pa1) {
    float ps = 0.f;
#pragma unroll
    for (int r = 0; r < 16; ++r) ps += p[r];
    { auto rr = __builtin_amdgcn_permlane32_swap(__float_as_uint(ps), __float_as_uint(ps), false, false); ps = __uint_as_float(rr[0]) + __uint_as_float(rr[1]); }
    l_reg = l_reg * alpha + ps;
    PK4(p, 0, pa0); PK4(p, 8, pa1);
}
__device__ __forceinline__ void qkt16(f32x16& p, const char* sb, const int (&kofs)[4], const bf16x8* qr) {
    p = f32x16{};
#pragma unroll
    for (int d0 = 0; d0 < 8; ++d0) { const bf16x8 kf = *reinterpret_cast<const bf16x8*>(sb + kofs[d0 & 3] + (d0 >> 2) * 128);
        p = __builtin_amdgcn_mfma_f32_32x32x16_bf16(kf, qr[d0], p, 0, 0, 0); }
}
__device__ __forceinline__ void pv16(f32x16* o, int vb, bf16x8 pa0, bf16x8 pa1) {
#define TRRD(dst, off) asm volatile("ds_read_b64_tr_b16 %0, %1 offset:%2" : "=&v"(dst) : "v"(vb), "i"(off) : "memory")
#define RD4(S, d0) do { TRRD(S##l0, (d0) * 512); TRRD(S##h0, (d0) * 512 + 4096); TRRD(S##l1, (d0) * 512 + 8192); TRRD(S##h1, (d0) * 512 + 12288); } while (0)
#define MM2(S, d0) do { o[d0] = __builtin_amdgcn_mfma_f32_32x32x16_bf16(pa0, (bf16x8){S##l0[0], S##l0[1], S##l0[2], S##l0[3], S##h0[0], S##h0[1], S##h0[2], S##h0[3]}, o[d0], 0, 0, 0);   \
        o[d0] = __builtin_amdgcn_mfma_f32_32x32x16_bf16(pa1, (bf16x8){S##l1[0], S##l1[1], S##l1[2], S##l1[3], S##h1[0], S##h1[1], S##h1[2], S##h1[3]}, o[d0], 0, 0, 0); } while (0)
#define WAITL(n) asm volatile("s_waitcnt lgkmcnt(" #n ")" ::: "memory")
    s16x4 Al0, Ah0, Al1, Ah1, Bl0, Bh0, Bl1, Bh1;
    RD4(A, 0);
    RD4(B, 1); WAITL(4); SBAR(); MM2(A, 0); SBAR();
    RD4(A, 2); WAITL(4); SBAR(); MM2(B, 1); SBAR();
    RD4(B, 3); WAITL(4); SBAR(); MM2(A, 2); SBAR();
    RD4(A, 4); WAITL(4); SBAR(); MM2(B, 3); SBAR();
    RD4(B, 5); WAITL(4); SBAR(); MM2(A, 4); SBAR();
    RD4(A, 6); WAITL(4); SBAR(); MM2(B, 5); SBAR();
    RD4(B, 7); WAITL(4); SBAR(); MM2(A, 6); SBAR();
    WAITL(0); SBAR(); MM2(B, 7);
#undef RD4
#undef MM2
#undef WAITL
#undef TRRD
}
template <int LD, int OLD>
__device__ __forceinline__ void diff_unit(const bf16* QKVb, bf16* Ob, int h, int P0, LAS unsigned char* ldsl, int tid, float lam, float oml, const float* subln, float bfar) {
    char* lds = (char*)ldsl;
    asm volatile("" : "+v"(tid));
    const int wid = __builtin_amdgcn_readfirstlane(tid >> 6), lane = tid & 63, r32 = lane & 31, hi = lane >> 5, rg = wid & 3, mp = wid >> 2;
    const int qlo = P0 + 32 * rg, qm = qlo + r32 - 4 * hi;
    const int NS = P0 / 32 + 4;
    float* wsf = (float*)(lds + LDS_WS) + wid * 64; float* li_l = wsf, * al_l = wsf + 32;
    const LAS float* lut = (const LAS float*)(ldsl + LDS_LUT) + mp * 272;
    bf16x8 qr[8];
    { const char* qb = (const char*)(QKVb + (size_t)qlo * LD + (2 * h + mp) * 128); const unsigned qoff = (unsigned)(r32 * LD + hi * 8) * 2u;
#pragma unroll
      for (int d0 = 0; d0 < 8; ++d0) qr[d0] = *(const bf16x8*)(qb + d0 * 32 + qoff); }
    unsigned koff, voff;
    { const int r = 4 * wid + (lane >> 4), c = (lane & 15) ^ (r & 7); koff = (unsigned)(r * LD + c * 8) * 2u;
      const int s = 2 * wid + (lane >> 5), kg = s >> 3, cb = s & 7, rr = (lane >> 2) & 7, q = lane & 3, kk = kg * 8 + rr, k = (kk & ~0xC) | ((kk & 4) << 1) | ((kk & 8) >> 1);
      voff = (unsigned)(k * LD + cb * 32 + q * 8) * 2u; }
    const char* Kg = (const char*)(QKVb + 2048 + (2 * h) * 128); const char* Vg = (const char*)(QKVb + 4096 + h * 256);
#define A2_DMA(u) do { if (mp == 0) { const size_t ro_ = (size_t)(u) * 32 * LD * 2; LAS unsigned char* sb_ = ldsl + ((u) & 3) * STG + wid * 1024;                  \
        __builtin_amdgcn_global_load_lds((const unsigned*)(Kg + ro_ + koff), (LAS unsigned*)(sb_), 16, 0, 0);                                                           \
        __builtin_amdgcn_global_load_lds((const unsigned*)(Kg + ro_ + 256 + koff), (LAS unsigned*)(sb_ + K2_OFF), 16, 0, 0);                                            \
        __builtin_amdgcn_global_load_lds((const unsigned*)(Vg + ro_ + voff), (LAS unsigned*)(sb_ + V_OFF), 16, 0, 0);                                                   \
        __builtin_amdgcn_global_load_lds((const unsigned*)(Vg + ro_ + (size_t)16 * LD * 2 + voff), (LAS unsigned*)(sb_ + V_OFF + 8192), 16, 0, 0);                       \
                      \
        __builtin_amdgcn_global_load_lds((const unsigned*)(Kg + ro_ + (size_t)16 * LD * 2 + koff), (LAS unsigned*)(sb_ + 4096), 16, 0, 0);                               \
        __builtin_amdgcn_global_load_lds((const unsigned*)(Kg + ro_ + (size_t)16 * LD * 2 + 256 + koff), (LAS unsigned*)(sb_ + 4096 + K2_OFF), 16, 0, 0);                \
        __builtin_amdgcn_global_load_lds((const unsigned*)(Vg + ro_ + (size_t)4 * LD * 2 + voff), (LAS unsigned*)(sb_ + 4096 + V_OFF), 16, 0, 0);                        \
        __builtin_amdgcn_global_load_lds((const unsigned*)(Vg + ro_ + (size_t)20 * LD * 2 + voff), (LAS unsigned*)(sb_ + 4096 + V_OFF + 8192), 16, 0, 0); } } while (0)
    int kofs[4];
#pragma unroll
    for (int dd = 0; dd < 4; ++dd) kofs[dd] = mp * K2_OFF + KSWZ(r32, (dd * 16 + hi * 8) * 2);
    const int vb0 = (int)(uintptr_t)lds + V_OFF + att::v_rd_base(lane);
    float m_reg = -1e30f, l_reg = 0.f; f32x16 o[8] = {};
    f32x16 pA, pB; float alA, alB; bf16x8 pa0, pa1;
#define RESC(a) do { if (__any((a) < 1.f)) { if (hi == 0) al_l[r32] = (a); asm volatile("s_waitcnt lgkmcnt(0)" ::: "memory");              \
                     for (int d_ = 0; d_ < 8; ++d_) for (int r = 0; r < 16; ++r) o[d_][r] *= al_l[crow(r, hi)]; } } while (0)
#define NEAR(u) ((u) * 32 + 144 > qlo)
#define SM_PART(PX, alX, u) do { if (NEAR(u)) bias_mask16(PX, qm - (u) * 32, lut); partialSM16(PX, m_reg, alX, NEAR(u) ? 0.f : bfar); } while (0)
    A2_DMA(0); A2_DMA(1);
    A2_WAITV(8); A2_BAR();
    A2_DMA(2);
    SBAR(); qkt16(pA, lds, kofs, qr);
    SM_PART(pA, alA, 0);
#define STEP(PX, alX, PY, alY, u) do {                                                                       \
        if ((u) + 1 < NS) A2_WAITV(8); else A2_WAITV(0);                                                      \
        A2_BAR();                                                                                            \
        if ((u) + 2 < NS) A2_DMA((u) + 2);                                                                   \
        SBAR(); qkt16_exp(PX, PY, (int)(uintptr_t)lds + ((u) & 3) * STG, kofs, qr);                            \
        finish_pack16(PY, alY, l_reg, pa0, pa1); SBAR();                                                     \
        pv16(o, vb0 + (((u) - 1) & 3) * STG, pa0, pa1);                                                       \
        SM_PART(PX, alX, u);                                                                                 \
        RESC(alX); } while (0)
    for (int u = 1; u + 1 < NS; u += 2) {
        STEP(pB, alB, pA, alA, u);
        STEP(pA, alA, pB, alB, u + 1);
    }
    STEP(pB, alB, pA, alA, NS - 1);
    finishSM16(pB, alB, l_reg, pa0, pa1); SBAR();
    pv16(o, vb0 + ((NS - 1) & 3) * STG, pa0, pa1);
    if (hi == 0) li_l[r32] = l_reg;
    asm volatile("s_waitcnt lgkmcnt(0)" ::: "memory");
    float rli[16];
#pragma unroll
    for (int r = 0; r < 16; ++r) rli[r] = __builtin_amdgcn_rcpf(li_l[crow(r, hi)]);
    A2_BAR();
    float* xch = (float*)(lds + rg * 32768);
    if (mp == 1) {
#pragma unroll
        for (int r = 0; r < 16; ++r) { const float f = lam * rli[r];
#pragma unroll
            for (int d0 = 0; d0 < 8; ++d0) xch[crow(r, hi) * 256 + d0 * 32 + r32] = o[d0][r] * f; }
    }
    A2_BAR();
    if (mp == 0) {
        int lane_e = lane; asm volatile("" : "+v"(lane_e)); const int r32e = lane_e & 31;
        float ssq[16];
#pragma unroll
        for (int r = 0; r < 16; ++r) { float s = 0.f;
#pragma unroll
            for (int d0 = 0; d0 < 8; ++d0) { const float v = o[d0][r] * rli[r] - xch[crow(r, hi) * 256 + d0 * 32 + r32]; o[d0][r] = v; s += v * v; }
            ssq[r] = s; }
#pragma unroll
        for (int st = 1; st < 32; st <<= 1) {
#pragma unroll
            for (int r = 0; r < 16; ++r) ssq[r] += __int_as_float(__builtin_amdgcn_ds_bpermute((lane_e ^ st) << 2, __float_as_int(ssq[r]))); }
        float g[8];
#pragma unroll
        for (int d0 = 0; d0 < 8; ++d0) g[d0] = subln[d0 * 32 + r32e] * oml;
        char* Ow = (char*)(Ob + (size_t)qlo * OLD + h * 256); const unsigned ooff = (unsigned)(4 * hi * OLD + r32e) * 2u;
#pragma unroll
        for (int r = 0; r < 16; ++r) { const float rs = __builtin_amdgcn_rsqf(ssq[r] * (1.0f / 256.0f) + 1e-6f); const int orow0 = (r & 3) + 8 * (r >> 2);
#pragma unroll
            for (int d0 = 0; d0 < 8; ++d0) { const float v = o[d0][r] * rs * g[d0]; const float vn = __int_as_float(__builtin_amdgcn_ds_bpermute((lane_e ^ 1) << 2, __float_as_int(v)));
                if ((r32 & 1) == 0) *(unsigned*)(Ow + (size_t)(orow0 * OLD + d0 * 32) * 2 + ooff) = cvtpk(v, vn); } }
    }
    A2_WAITV(0); A2_BAR();
#undef A2_DMA
#undef RESC
#undef NEAR
#undef SM_PART
#undef STEP
}
#undef SBAR
}
template <bool EXIT>
__device__ __forceinline__ void attnB_phase(Frame& F, const bf16* Q, const bf16* KV, bf16* O) {
    int tid = CUR_TID(F);
    char* lds = (char*)(F.lds + RING_OFF);
    int vc0 = F.vcu; asm volatile("" : "+s"(vc0));
    for (int vc = vc0; vc < 256; vc += F.G) {
        const int bh = vc >> 3, p = vc & 7, b = bh >> 4, h = bh & 15;
        const bf16* Qb = Q + (size_t)b * SEQ * DM + h * 128; const bf16* Kb = KV + (size_t)b * SEQ * NKV + h * 128; const bf16* Vb = Kb + DM;
        bf16* Ob = O + (size_t)b * SEQ * DM + h * 128;
        for (int i = 0; i < 4; ++i) {
            const int qb = ((i >> 1) << 4) + ((i & 1) ? 15 - p : p);
            const att::BlockRef cur{Qb + (size_t)qb * 256 * DM, Kb, Vb, Ob + (size_t)qb * 256 * DM, qb * 256};
            att::sb_block<DM, NKV, NKV, DM, EXIT>(cur, lds, tid);
        }
    }
}

__device__ __forceinline__ void attnA2_phase(Frame& F, const bf16* QKV, bf16* O, const float* rel_bias, const float* lamv, const float* subln, int layer) {
    int tid = CUR_TID(F);
    const int lane = tid & 63;
    asm volatile("" : "+s"(layer)); const float lambda_init = layer == 0 ? 0.2f : 0.35550906759096924f;
    float s01 = 0.f, s23 = 0.f;
    for (int i = lane; i < 128; i += 64) { s01 += lamv[i] * lamv[128 + i]; s23 += lamv[256 + i] * lamv[384 + i]; }
    s01 = wave_sum(s01); s23 = wave_sum(s23);
    const float lam = expf(s01) - expf(s23) + lambda_init, oml = 1.0f - lambda_init;
    int vc0 = F.vcu; asm volatile("" : "+s"(vc0));
    for (int vc = vc0; vc < 256; vc += F.G) {
        const int bh = vc >> 4, p = vc & 15, b = bh >> 3, h = bh & 7;
        __syncthreads();
        asm volatile("" : "+v"(tid));
        { LAS float* lut = (LAS float*)(F.lds + att2::LDS_LUT);
          for (int i = tid; i < 2 * 272; i += 512) { const int mpi = i >= 272 ? 1 : 0; int n = i - mpi * 272 - 64; n = n < 0 ? 0 : n; lut[i] = rel_bias[t5_bucket(n) * 16 + 2 * h + mpi] * (1.0f / att::SCALE); } }
        const float bfar = rel_bias[31 * 16 + 2 * h + (tid >> 8)] * (1.0f / att::SCALE);
        __syncthreads();
        const bf16* QKVb = QKV + (size_t)b * SEQ * NQKV; bf16* Ob = O + (size_t)b * SEQ * DM;
        for (int i = 0; i < 4; ++i) {
            const int qb = ((i >> 1) << 5) + ((i & 1) ? 31 - p : p);
            att2::diff_unit<NQKV, DM>(QKVb, Ob, h, qb * 128, F.lds, tid, lam, oml, subln, bfar);
        }
    }
}

typedef const __attribute__((address_space(4))) Args* KArgs;
#define KARG() ({ KArgs ap_ = (KArgs)__builtin_amdgcn_kernarg_segment_ptr(); asm volatile("" : "+s"(ap_)); ap_; })
#define IN(k) (KARG()->in[k])
#define WS() (KARG()->ws)
__global__ void __launch_bounds__(NWAVES * 64, 2) mk_fwd(Args args_unused) {
    extern __shared__ __attribute__((aligned(16))) unsigned char lds[];
    Frame F;
    F.lds = (LAS unsigned char*)lds;
    F.MISC = (volatile LAS unsigned*)(F.lds + MISC_OFF);
    F.wave = __builtin_amdgcn_readfirstlane((int)threadIdx.x >> 6);
    F.G = gridDim.x; { const int bx = blockIdx.x; F.vcu = (F.G % 8 == 0) ? (bx % 8) * (F.G / 8) + bx / 8 : bx; }
    F.ctl = (gu32*)(WS() + WS_CTL);
    for (int u = threadIdx.x; u < (LDS_BYTES - LDSCTL_OFF) / 4; u += NWAVES * 64) ((LAS unsigned*)(F.lds + LDSCTL_OFF))[u] = 0u;
    __syncthreads();
    (void)xcd_barrier_post((unsigned*)(F.ctl + CW_BAR), F.MISC + 8);
#define GRID_BAR() do { XcdBarrier b_; b_.bar = (unsigned*)(WS() + WS_CTL) + CW_BAR; b_.x = xb_xcc_id(); b_.st = F.MISC + 8; b_.tid = CUR_TID(F); xcd_barrier(b_); } while (0)
#define XO() (KARG()->out)
#define WSP(off) ((bf16*)(WS() + (off)))
#define XN WSP(WS_XN)
#define OB WSP(WS_OB)
#define HB WSP(WS_H)
#define QKV WSP(WS_QKV)
#define KVSH WSP(WS_KVSH)

#define SSV(v) ((float*)(WS() + WS_SS) + (size_t)(v) * M * 32)
#define RSTAB ((PG8_LAS float*)(F.lds + RSTD_OFF))
    {
        LAS float* scr = (LAS float*)(F.lds + RING_OFF + F.wave * 16384);
        transpose_group<true >(F, F.vcu, F.G, IN(2), IN(1), 4, DM, NWI, (bf16*)(WS() + WS_WI_PRE), scr);
        transpose_group<true >(F, F.vcu, F.G, IN(6), IN(5), 4, DM, NWI, (bf16*)(WS() + WS_WI_POST), scr);
        transpose_group<false>(F, F.vcu, F.G, IN(9), IN(4), 2, DM, NQKV, (bf16*)(WS() + WS_AWQKV), scr);
        transpose_group<false>(F, F.vcu, F.G, IN(16), IN(15), 1, DM, NKV, (bf16*)(WS() + WS_BWKV), scr);
        cast_rows(F, IN(0), XN, SSV(0));
    }
    GRID_BAR();

    for (int l = 0; l < 4; ++l) {
        if (l == 2) {
            pg8::Gemm g{XN, (const bf16*)(WS() + WS_BWKV), M, NKV, DM}; pg8::StaticOrder S; S.init(M, NKV, F.G, (int)blockIdx.x);
            pg8::preload_rstd(S, SSV(6), RSTAB, CUR_TID(F));
            pg8::EpiBf16 E{KVSH, NKV, RSTAB};
            pg8::gemm_phase<pg8::EpiBf16, pg8::StaticOrder, true, true>(F.lds + RING_OFF, g, S, E, CUR_TID(F));
        }
        for (int s = 0; s < 2; ++s) {
            {
                const bf16* wi = (const bf16*)(WS() + (s ? WS_WI_POST : WS_WI_PRE) + (size_t)l * SZ_WI);
                pg8::Gemm g{XN, wi, M, NWI, DM}; pg8::StaticOrder S; S.init(M, NWI, F.G, (int)blockIdx.x);
                pg8::preload_rstd(S, SSV(3 * l + 2 * s), RSTAB, CUR_TID(F));
                pg8::EpiSwiGLU E{HB, DFF, RSTAB};
                pg8::gemm_phase<pg8::EpiSwiGLU, pg8::StaticOrder, false, true>(F.lds + RING_OFF, g, S, E, CUR_TID(F));
            }
            {
                const int rem_ = ((M / 256) * (NWI / 256)) % F.G, c_ = (int)blockIdx.x;
                if (rem_ == 0 || c_ >= rem_) {
                    const int part_ = rem_ ? c_ - rem_ : F.vcu, nparts_ = rem_ ? F.G - rem_ : F.G;
                    LAS float* scr = (LAS float*)(F.lds + RING_OFF + F.wave * 16384);
                    transpose_group<false>(F, part_, nparts_, (s ? IN(7) : IN(3)) + (size_t)l * DFF * DM, nullptr, 1, DFF, DM, (bf16*)(WS() + (s ? WS_WO_POST : WS_WO_PRE) + (size_t)l * SZ_WO), scr);
                    const float* xw = nullptr; const float* xg = nullptr; bf16* xd = nullptr; float xs = 1.0f;
                    if (s == 0) { if (l < 2) { xw = IN(14) + (size_t)l * DM * DM; xd = (bf16*)(WS() + WS_AWO + (size_t)l * SZ_DD); } else { xw = IN(18) + (size_t)(l - 2) * DM * DM; xd = (bf16*)(WS() + WS_BWO + (size_t)(l - 2) * SZ_DD); } }
                    else if (l == 1 || l == 2) { xw = IN(17) + (size_t)(l - 1) * DM * DM; xg = IN(4) + (size_t)(l + 1) * DM; xd = (bf16*)(WS() + WS_BWQ + (size_t)(l - 1) * SZ_DD); xs = att::SCALE * 1.4426950408889634f; }
                    if (xw) transpose_group<false>(F, part_, nparts_, xw, xg, 1, DM, DM, xd, scr, xs);
                }
            }
            GRID_BAR();
            {
                const bf16* wo = (const bf16*)(WS() + (s ? WS_WO_POST : WS_WO_PRE) + (size_t)l * SZ_WO);
                pg8::Gemm g{HB, wo, M, DM, DFF}; pg8::StaticOrder S; S.init(M, DM, F.G, (int)blockIdx.x);
                if (l == 3 && s == 1) {
                    pg8::EpiResid16<true> E{XN, nullptr, XO(), DM, 0.5f};
                    pg8::gemm_phase<pg8::EpiResid16<true>, pg8::StaticOrder, true, true>(F.lds + RING_OFF, g, S, E, CUR_TID(F));
                } else {
                    pg8::EpiResid16<false> E{XN, SSV(3 * l + 2 * s + 1), nullptr, DM, 0.5f};
                    pg8::gemm_phase<pg8::EpiResid16<false>, pg8::StaticOrder, false, true>(F.lds + RING_OFF, g, S, E, CUR_TID(F));
                }
            }
            GRID_BAR();
            if (s == 0) {
                if (l < 2) {
                    { LAS float* gl = (LAS float*)(F.lds + QKG_OFF); const int t_ = CUR_TID(F);
                      if (t_ < 256) gl[t_] = (t_ < 128 ? IN(10) + (size_t)l * HD : IN(11) + (size_t)l * HD - 128)[t_]; }
                    pg8::Gemm g{XN, (const bf16*)(WS() + WS_AWQKV + (size_t)l * SZ_AWQKV), M, NQKV, DM}; pg8::StaticOrder S; S.init(M, NQKV, F.G, (int)blockIdx.x);
                    pg8::preload_rstd(S, SSV(3 * l + 1), RSTAB, CUR_TID(F));
                    pg8::EpiQKV E{QKV, NQKV, (PG8_LAS float*)(F.lds + QKX_OFF), (const PG8_LAS float*)(F.lds + QKG_OFF), RSTAB};
                    pg8::gemm_phase<pg8::EpiQKV, pg8::StaticOrder, true, true>(F.lds + RING_OFF, g, S, E, CUR_TID(F));
                } else {
                    pg8::Gemm g{XN, (const bf16*)(WS() + WS_BWQ + (size_t)(l - 2) * SZ_DD), M, DM, DM}; pg8::StaticOrder S; S.init(M, DM, F.G, (int)blockIdx.x);
                    pg8::preload_rstd(S, SSV(3 * l + 1), RSTAB, CUR_TID(F));
                    pg8::EpiBf16 E{QKV, DM, RSTAB};
                    pg8::gemm_phase<pg8::EpiBf16, pg8::StaticOrder, true, true>(F.lds + RING_OFF, g, S, E, CUR_TID(F));
                }
                GRID_BAR();
                if (l < 2) {
                    attnA2_phase(F, QKV, OB, IN(8), IN(12) + (size_t)l * 512, IN(13) + (size_t)l * 256, l);
                } else {
                    attnB_phase<true>(F, QKV, KVSH, OB);
                }
                GRID_BAR();
                {
                    const bf16* w = (l < 2) ? (const bf16*)(WS() + WS_AWO + (size_t)l * SZ_DD) : (const bf16*)(WS() + WS_BWO + (size_t)(l - 2) * SZ_DD);
                    pg8::Gemm g{OB, w, M, DM, DM}; pg8::StaticOrder S; S.init(M, DM, F.G, (int)blockIdx.x);
                    pg8::EpiResid16<false> E{XN, SSV(3 * l + 2), nullptr, DM, 1.0f};
                    pg8::gemm_phase<pg8::EpiResid16<false>, pg8::StaticOrder, false, true>(F.lds + RING_OFF, g, S, E, CUR_TID(F));
                }
                GRID_BAR();
            }
        }
    }
#undef SSV
#undef RSTAB
#undef GRID_BAR
#undef XN
#undef OB
#undef HB
#undef QKV
#undef KVSH
}

extern "C" void kernel_launch(void* const* d_in, const int* in_sizes, int n_in, void* d_out, int out_size, void* d_ws, size_t ws_size, hipStream_t stream) {
    static int grid = 0;
    if (grid == 0) {
        if (n_in != 19 || in_sizes[0] != M * DM || out_size != M * DM || ws_size < WS_END) { fprintf(stderr, "kernel_launch: shape/workspace mismatch: n_in %d in0 %d out %d ws %zu (need %zu); nothing launched\n", n_in, n_in > 0 ? in_sizes[0] : -1, out_size, ws_size, (size_t)WS_END); grid = -1; return; }
        int dev = 0, cus = 0, per_cu = 0;
        if (hipGetDevice(&dev) != hipSuccess || hipDeviceGetAttribute(&cus, hipDeviceAttributeMultiprocessorCount, dev) != hipSuccess) { fprintf(stderr, "kernel_launch: device query failed\n"); grid = -1; return; }
        if (hipFuncSetAttribute((const void*)mk_fwd, hipFuncAttributeMaxDynamicSharedMemorySize, LDS_BYTES) != hipSuccess) { fprintf(stderr, "kernel_launch: hipFuncSetAttribute failed\n"); grid = -1; return; }
        if (hipOccupancyMaxActiveBlocksPerMultiprocessor(&per_cu, (const void*)mk_fwd, NWAVES * 64, LDS_BYTES) != hipSuccess || per_cu < 1)
            fprintf(stderr, "kernel_launch: note: occupancy query reports %d workgroups per CU\n", per_cu);
        (void)hipGetLastError();
        grid = cus;
    }
    if (grid < 0) return;
    if (hipMemsetAsync((char*)d_ws + WS_CTL, 0, CTL_ZERO_BYTES, stream) != hipSuccess) { fprintf(stderr, "kernel_launch: memset failed\n"); return; }
    Args a{};
    for (int i = 0; i < 19; ++i) a.in[i] = (const float*)d_in[i];
    a.out = (float*)d_out; a.ws = (unsigned char*)d_ws;
    hipLaunchKernelGGL(mk_fwd, dim3(grid), dim3(NWAVES * 64), LDS_BYTES, stream, a);
    const hipError_t le = hipPeekAtLastError();
    if (le != hipSuccess) fprintf(stderr, "kernel_launch: launch failed: %s\n", hipGetErrorName(le));
}
```

```cpp
#include <hip/hip_runtime.h>
__device__ __forceinline__ int lane_id() { unsigned z; asm volatile("s_mov_b32 %0, 0" : "=s"(z)); return (int)__builtin_amdgcn_mbcnt_hi(~0u, __builtin_amdgcn_mbcnt_lo(~0u, z)); }
__device__ __forceinline__ float shx(float v, int o) { return __int_as_float(__builtin_amdgcn_ds_bpermute((lane_id() ^ o) << 2, __float_as_int(v))); }
#include <hip/hip_runtime.h>
#include <cstdio>
#include <cstdint>
namespace pg8 {
#define PG8_LAS __attribute__((address_space(3)))
typedef unsigned short bf16_t;
typedef short bf16x8 __attribute__((ext_vector_type(8)));
typedef float f32x4 __attribute__((ext_vector_type(4)));
typedef unsigned u32x4 __attribute__((ext_vector_type(4)));
constexpr int BM = 256, BK = 64, HALF = 128, HTB = HALF * BK * 2  , STAGE_BYTES = 8 * HTB, NXCD = 8, WGM = 8;

__host__ __device__ __forceinline__ int lds_byte(int r, int c) { const int st = (r >> 4) * 2 + (c >> 5), rr = r & 15, cc = c & 31, ob = rr * 64 + cc * 2; return st * 1024 + (ob ^ (((ob >> 9) & 1) << 5)); }
__host__ __device__ __forceinline__ void stage_rc(int b, int& R, int& C) { const int st = b / 1024, sb = b % 1024, swz = sb ^ (((sb >> 9) & 1) << 5); R = (st >> 1) * 16 + swz / 64; C = (st & 1) * 32 + (swz % 64) / 2; }
__host__ __device__ __forceinline__ int perm32(int rho) { const int n = rho >> 4, i = rho & 15; return 8 * (i >> 2) + 4 * n + (i & 3); }

struct Unit { int pm, pn, idx; };
struct Gemm { const bf16_t* A; const bf16_t* Bt; int M, N, K; };

struct StaticOrder {
    int nM, nN, nwg, G, c;
    __host__ __device__ void init(int M, int N, int G_, int c_) { nM = M / BM; nN = N / BM; nwg = nM * nN; G = G_; c = c_; }
    __host__ __device__ bool next(int i, Unit& u) const {
        const long L = (long)i * G + c; if (L >= nwg) return false;
        int wgid = (int)L; { const int q = nwg / NXCD, r = nwg % NXCD, xcd = wgid % NXCD, off = wgid / NXCD; wgid = (xcd < r ? xcd * (q + 1) : r * (q + 1) + (xcd - r) * q) + off; }
        const int nig = WGM * nN, gid = wgid / nig, fm = gid * WGM, gsz = (nM - fm) < WGM ? (nM - fm) : WGM;
        u.pm = fm + ((wgid % nig) % gsz); u.pn = (wgid % nig) / gsz; u.idx = i; return true;
    }
    __device__ __forceinline__ void a_ready(const Unit&) const {}
    __device__ __forceinline__ void done(const Unit&) const {}
};

__device__ __forceinline__ unsigned cvt_pk_bf16(float lo, float hi) { unsigned r; asm volatile("v_cvt_pk_bf16_f32 %0, %1, %2" : "=v"(r) : "v"(lo), "v"(hi)); return r; }
template <class Sched>
__device__ __forceinline__ void preload_rstd(const Sched& S, const float* ss, PG8_LAS float* rs, int tid) {
    Unit u; const int sub = tid & 7, r0 = tid >> 3;
    int pm_have = -1; float val[4] = {0.f, 0.f, 0.f, 0.f};
    for (int i = 0; S.next(i, u); ++i) {
        if (u.pm != pm_have) {
            pm_have = u.pm;
#pragma unroll
            for (int j = 0; j < 4; ++j) {
                const f32x4 a = *(const f32x4*)(ss + (size_t)(u.pm * BM + r0 + 64 * j) * 32 + sub * 4); float s = (a[0] + a[1]) + (a[2] + a[3]);
                s += shx(s, 1); s += shx(s, 2); s += shx(s, 4);
                val[j] = __builtin_amdgcn_rsqf(s * (1.0f / 2048.0f) + 1e-6f); }
        }
        if (sub == 0) {
#pragma unroll
            for (int j = 0; j < 4; ++j) rs[i * 256 + r0 + 64 * j] = val[j]; }
    }
    asm volatile("s_waitcnt lgkmcnt(0)" ::: "memory"); __syncthreads();
}
__device__ __forceinline__ void row_rstd(float (&rs)[2][4], const PG8_LAS float* tab, const Unit& u, int wr, int fr) {
#pragma unroll
    for (int ai = 0; ai < 2; ++ai)
#pragma unroll
        for (int m = 0; m < 4; ++m) rs[ai][m] = tab[u.idx * 256 + ai * HALF + wr * 64 + m * 16 + fr];
}
struct EpiBf16 {
    static constexpr bool PERM = true, AFTER_DRAIN = false;
    bf16_t* O; int ldc; const PG8_LAS float* rstab;
    __device__ __forceinline__ void operator()(const f32x4 (&acc)[2][2][4][2], const Unit& u, int wr, int wc, int fr, int fq) const {
        const int row0 = u.pm * BM + wr * 64 + fr, col0 = u.pn * BM + wc * 32 + 8 * fq;
        float rs[2][4]; row_rstd(rs, rstab, u, wr, fr);
#pragma unroll
        for (int ai = 0; ai < 2; ++ai)
#pragma unroll
            for (int m = 0; m < 4; ++m) { bf16_t* rowp = O + (size_t)(row0 + ai * HALF + m * 16) * ldc + col0; const float r = rs[ai][m];
#pragma unroll
                for (int bj = 0; bj < 2; ++bj) { const f32x4 v0 = acc[ai][bj][m][0] * r, v1 = acc[ai][bj][m][1] * r;
                    u32x4 w; w.x = cvt_pk_bf16(v0[0], v0[1]); w.y = cvt_pk_bf16(v0[2], v0[3]); w.z = cvt_pk_bf16(v1[0], v1[1]); w.w = cvt_pk_bf16(v1[2], v1[3]);
                    *(u32x4*)(rowp + bj * HALF) = w; } }
    }
};
struct EpiQKV {
    static constexpr bool PERM = true, AFTER_DRAIN = false;
    bf16_t* O; int ldc; PG8_LAS float* xs; const PG8_LAS float* gains; const PG8_LAS float* rstab;
    __device__ __forceinline__ void operator()(const f32x4 (&acc)[2][2][4][2], const Unit& u, int wr, int wc, int fr, int fq) const {
        const int row0 = u.pm * BM + wr * 64 + fr, col0 = u.pn * BM + wc * 32 + 8 * fq;
        const bool nrm = u.pn < 16;
        float rs[2][4]; row_rstd(rs, rstab, u, wr, fr);
        if (nrm) {
#pragma unroll
            for (int ai = 0; ai < 2; ++ai)
#pragma unroll
                for (int m = 0; m < 4; ++m)
#pragma unroll
                    for (int bj = 0; bj < 2; ++bj) { const f32x4 a = acc[ai][bj][m][0] * rs[ai][m], b = acc[ai][bj][m][1] * rs[ai][m];
                        float s = ((a[0] * a[0] + a[1] * a[1]) + (a[2] * a[2] + a[3] * a[3])) + ((b[0] * b[0] + b[1] * b[1]) + (b[2] * b[2] + b[3] * b[3]));
                        s += shx(s, 16); s += shx(s, 32);
                        if (fq == 0) xs[(((wr * 128 + ai * 64 + m * 16 + fr) * 2 + bj) << 2) + wc] = s; }
        }
        asm volatile("s_waitcnt lgkmcnt(0)" ::: "memory"); __builtin_amdgcn_s_barrier(); asm volatile("" ::: "memory");
        f32x4 g0 = {1.f, 1.f, 1.f, 1.f}, g1 = g0;
        if (nrm) { const PG8_LAS float* gp = gains + (u.pn >= 8 ? 128 : 0) + wc * 32 + 8 * fq; g0 = *(const PG8_LAS f32x4*)gp; g1 = *(const PG8_LAS f32x4*)(gp + 4); }
#pragma unroll
        for (int ai = 0; ai < 2; ++ai)
#pragma unroll
            for (int m = 0; m < 4; ++m) { bf16_t* rowp = O + (size_t)(row0 + ai * HALF + m * 16) * ldc + col0;
#pragma unroll
                for (int bj = 0; bj < 2; ++bj) { f32x4 v0 = acc[ai][bj][m][0] * rs[ai][m], v1 = acc[ai][bj][m][1] * rs[ai][m];
                    if (nrm) { const f32x4 p = *(const PG8_LAS f32x4*)(xs + (((wr * 128 + ai * 64 + m * 16 + fr) * 2 + bj) << 2));
                        const float r = __builtin_amdgcn_rsqf(((p[0] + p[1]) + (p[2] + p[3])) * (1.0f / 128.0f) + 1e-6f); v0 = v0 * r * g0; v1 = v1 * r * g1; }
                    u32x4 w; w.x = cvt_pk_bf16(v0[0], v0[1]); w.y = cvt_pk_bf16(v0[2], v0[3]); w.z = cvt_pk_bf16(v1[0], v1[1]); w.w = cvt_pk_bf16(v1[2], v1[3]);
                    *(u32x4*)(rowp + bj * HALF) = w; } }
    }
};
__device__ __forceinline__ f32x4 silu_mul4(f32x4 g, f32x4 u, float nl, float r2) {
    f32x4 t = g * nl;
    t = (f32x4){__builtin_amdgcn_exp2f(t[0]), __builtin_amdgcn_exp2f(t[1]), __builtin_amdgcn_exp2f(t[2]), __builtin_amdgcn_exp2f(t[3])} + 1.0f;
    t = (f32x4){__builtin_amdgcn_rcpf(t[0]), __builtin_amdgcn_rcpf(t[1]), __builtin_amdgcn_rcpf(t[2]), __builtin_amdgcn_rcpf(t[3])} * r2;
    return (g * u) * t;
}
struct EpiSwiGLU {
    static constexpr bool PERM = true, AFTER_DRAIN = false;
    bf16_t* O; int ldc; const PG8_LAS float* rstab;
    __device__ __forceinline__ void operator()(const f32x4 (&acc)[2][2][4][2], const Unit& u, int wr, int wc, int fr, int fq) const {
        const int row0 = u.pm * BM + wr * 64 + fr, col0 = u.pn * HALF + wc * 32 + 8 * fq;
        float rs[2][4]; row_rstd(rs, rstab, u, wr, fr);
#pragma unroll
        for (int ai = 0; ai < 2; ++ai)
#pragma unroll
            for (int m = 0; m < 4; ++m) { bf16_t* rowp = O + (size_t)(row0 + ai * HALF + m * 16) * ldc + col0; const float r = rs[ai][m], nl = r * -1.4426950408889634f, r2 = r * r;
                const f32x4 g0 = acc[ai][0][m][0], g1 = acc[ai][0][m][1], u0 = acc[ai][1][m][0], u1 = acc[ai][1][m][1];
                const f32x4 h0 = silu_mul4(g0, u0, nl, r2), h1 = silu_mul4(g1, u1, nl, r2);
                u32x4 w; w.x = cvt_pk_bf16(h0[0], h0[1]); w.y = cvt_pk_bf16(h0[2], h0[3]); w.z = cvt_pk_bf16(h1[0], h1[1]); w.w = cvt_pk_bf16(h1[2], h1[3]);
                *(u32x4*)rowp = w; }
    }
};
template <bool FINAL>
struct EpiResid16 {
    static constexpr bool PERM = true, AFTER_DRAIN = false;
    bf16_t* x16; float* ss; float* outf; int ldc; float scale;
    __device__ __forceinline__ void operator()(const f32x4 (&acc)[2][2][4][2], const Unit& u, int wr, int wc, int fr, int fq) const {
        const int row0 = u.pm * BM + wr * 64 + fr, col0 = u.pn * BM + wc * 32 + 8 * fq;
        u32x4 b[2][4][2];
#pragma unroll
        for (int ai = 0; ai < 2; ++ai)
#pragma unroll
            for (int m = 0; m < 4; ++m)
#pragma unroll
                for (int bj = 0; bj < 2; ++bj) b[ai][m][bj] = *(const u32x4*)(x16 + (size_t)(row0 + ai * HALF + m * 16) * ldc + col0 + bj * HALF);
        asm volatile("" ::: "memory");
#pragma unroll
        for (int ai = 0; ai < 2; ++ai)
#pragma unroll
            for (int m = 0; m < 4; ++m) { const int row = row0 + ai * HALF + m * 16; const size_t off = (size_t)row * ldc + col0; float part = 0.f;
#pragma unroll
                for (int bj = 0; bj < 2; ++bj) { const u32x4 w0 = b[ai][m][bj];
                    f32x4 v0 = {__uint_as_float(w0.x << 16), __uint_as_float(w0.x & 0xffff0000u), __uint_as_float(w0.y << 16), __uint_as_float(w0.y & 0xffff0000u)};
                    f32x4 v1 = {__uint_as_float(w0.z << 16), __uint_as_float(w0.z & 0xffff0000u), __uint_as_float(w0.w << 16), __uint_as_float(w0.w & 0xffff0000u)};
                    v0 = v0 + acc[ai][bj][m][0] * scale; v1 = v1 + acc[ai][bj][m][1] * scale;
                    if (FINAL) { *(f32x4*)(outf + off + bj * HALF) = v0; *(f32x4*)(outf + off + bj * HALF + 4) = v1; }
                    else { u32x4 w; w.x = cvt_pk_bf16(v0[0], v0[1]); w.y = cvt_pk_bf16(v0[2], v0[3]); w.z = cvt_pk_bf16(v1[0], v1[1]); w.w = cvt_pk_bf16(v1[2], v1[3]);
                        *(u32x4*)(x16 + off + bj * HALF) = w;
                        const float r0 = __uint_as_float(w.x << 16), r1 = __uint_as_float(w.x & 0xffff0000u), r2 = __uint_as_float(w.y << 16), r3 = __uint_as_float(w.y & 0xffff0000u);
                        const float r4 = __uint_as_float(w.z << 16), r5 = __uint_as_float(w.z & 0xffff0000u), r6 = __uint_as_float(w.w << 16), r7 = __uint_as_float(w.w & 0xffff0000u);
                        part += ((r0 * r0 + r1 * r1) + (r2 * r2 + r3 * r3)) + ((r4 * r4 + r5 * r5) + (r6 * r6 + r7 * r7)); } }
                if (!FINAL) { part += shx(part, 16); part += shx(part, 32);
                    if (fq == 0) ss[(size_t)row * 32 + u.pn * 4 + wc] = part; } }
    }
};

template <class Epi, class Sched, bool ALIGN_EPI = false, bool SP2 = false>
__device__ __forceinline__ void gemm_phase(PG8_LAS unsigned char* lds, const Gemm g, const Sched& S, const Epi& E, int tid_in) {
    int tid_ = tid_in; asm volatile("" : "+v"(tid_));
    const int tid = tid_, wid = __builtin_amdgcn_readfirstlane(tid >> 6), lane = tid & 63, wr = wid >> 2, wc = wid & 3, fr = lane & 15, fq = lane >> 4;
    const int K = g.K, nt = K / BK;
    unsigned voffA[2], voffB[2];
#pragma unroll
    for (int i = 0; i < 2; ++i) { int R, C; stage_rc(tid * 16 + i * 8192, R, C); const int Rb = Epi::PERM ? ((R & ~31) + perm32(R & 31)) : R;
        voffA[i] = (unsigned)(R * K + C) * 2u; voffB[i] = (unsigned)(Rb * K + C) * 2u; }
    const size_t kstep = (size_t)(BK * 2);
    const size_t hstep = (size_t)HALF * K * 2;
    const size_t tstep = 2 * hstep;
    const unsigned ldsw = (unsigned)wid * 1024u;
    const int aoff = lds_byte(wr * 64 + fr, fq * 8), boff = lds_byte(wc * 32 + fr, fq * 8);
#define PG8_SA(b, h) (((b) * 2 + (h)) * HTB)
#define PG8_SB(b, h) ((4 + (b) * 2 + (h)) * HTB)
#define PG8_STAGE(bufoff, gbase, voff) do { _Pragma("unroll") for (int _i = 0; _i < 2; ++_i) \
        __builtin_amdgcn_global_load_lds((const unsigned*)((const char*)(gbase) + (voff)[_i]), (PG8_LAS unsigned*)(lds + (bufoff) + ldsw + _i * 8192), 16, 0, 0); } while (0)
#define PG8_LDA(dst, b, h) do { _Pragma("unroll") for (int m = 0; m < 4; ++m) _Pragma("unroll") for (int k = 0; k < 2; ++k) dst[m][k] = *(const PG8_LAS bf16x8*)(lds + PG8_SA(b, h) + aoff + m * 2048 + k * 1024); } while (0)
#define PG8_LDB(dst, b, h) do { _Pragma("unroll") for (int n = 0; n < 2; ++n) _Pragma("unroll") for (int k = 0; k < 2; ++k) dst[n][k] = *(const PG8_LAS bf16x8*)(lds + PG8_SB(b, h) + boff + n * 2048 + k * 1024); } while (0)
#define PG8_PRIO(x) __builtin_amdgcn_s_setprio(x)
#define PG8_MMA(ai, bj, At, Bt) do { PG8_PRIO(1); _Pragma("unroll") for (int m = 0; m < 4; ++m) _Pragma("unroll") for (int n = 0; n < 2; ++n) _Pragma("unroll") for (int k = 0; k < 2; ++k) \
        acc[ai][bj][m][n] = __builtin_amdgcn_mfma_f32_16x16x32_bf16(Bt[n][k], At[m][k], acc[ai][bj][m][n], 0, 0, 0); PG8_PRIO(0); } while (0)
#define PG8_WAIT_V(n) asm volatile("s_waitcnt vmcnt(" #n ")" ::: "memory")
#define PG8_WAIT_L(n) asm volatile("s_waitcnt lgkmcnt(" #n ")" ::: "memory")
#define PG8_BAR __builtin_amdgcn_s_barrier()
#define PG8_SCHED __builtin_amdgcn_sched_barrier(0)
    Unit cur, nxt; int ui = 0;
    if (!S.next(0, cur)) return;
    f32x4 acc[2][2][4][2];
#pragma unroll
    for (int a = 0; a < 2; ++a)
#pragma unroll
        for (int b = 0; b < 2; ++b)
#pragma unroll
            for (int m = 0; m < 4; ++m)
#pragma unroll
                for (int n = 0; n < 2; ++n) acc[a][b][m][n] = (f32x4){0.f, 0.f, 0.f, 0.f};
    bf16x8 At[4][2], B0[2][2], B1[2][2];
    const char* cA = (const char*)g.A + (size_t)cur.pm * tstep; const char* cB = (const char*)g.Bt + (size_t)cur.pn * tstep;
    S.a_ready(cur);
    if constexpr (SP2) {
        PG8_STAGE(PG8_SB(0, 0), cB, voffB); PG8_STAGE(PG8_SB(0, 1), cB + hstep, voffB); PG8_STAGE(PG8_SA(0, 0), cA, voffA); PG8_STAGE(PG8_SA(0, 1), cA + hstep, voffA);
        if (wr == 1) PG8_BAR;
        PG8_WAIT_V(2); PG8_BAR;
        PG8_STAGE(PG8_SB(1, 0), cB + kstep, voffB); PG8_STAGE(PG8_SA(1, 0), cA + kstep, voffA); PG8_STAGE(PG8_SB(1, 1), cB + hstep + kstep, voffB);
        PG8_WAIT_V(6); PG8_BAR;
    } else {
        PG8_STAGE(PG8_SB(0, 0), cB, voffB); PG8_STAGE(PG8_SA(0, 0), cA, voffA); PG8_STAGE(PG8_SB(0, 1), cB + hstep, voffB); PG8_STAGE(PG8_SA(0, 1), cA + hstep, voffA);
        if (wr == 1) PG8_BAR;
        PG8_WAIT_V(4); PG8_BAR;
        PG8_STAGE(PG8_SB(1, 0), cB + kstep, voffB); PG8_STAGE(PG8_SA(1, 0), cA + kstep, voffA); PG8_STAGE(PG8_SB(1, 1), cB + hstep + kstep, voffB);
        PG8_WAIT_V(6); PG8_BAR;
    }
    for (;;) {
        const bool has_next = S.next(ui + 1, nxt);
        const char* nA = has_next ? (const char*)g.A + (size_t)nxt.pm * tstep : cA; const char* nB = has_next ? (const char*)g.Bt + (size_t)nxt.pn * tstep : cB;
        for (int t = 0; t < nt; t += 2) {
            const bool last = (t == nt - 2);
            const char* a1 = cA + (size_t)(t + 1) * kstep;
            const char* a2 = last ? nA : cA + (size_t)(t + 2) * kstep; const char* b2 = last ? nB : cB + (size_t)(t + 2) * kstep;
            const char* a3 = a2 + kstep; const char* b3 = b2 + kstep;
            if (last && has_next) S.a_ready(nxt);
            if constexpr (SP2) {
            PG8_LDB(B0, 0, 0); PG8_LDB(B1, 0, 1); PG8_SCHED; PG8_LDA(At, 0, 0); PG8_STAGE(PG8_SA(1, 1), a1 + hstep, voffA);
            PG8_WAIT_V(8); PG8_WAIT_L(0); PG8_BAR; PG8_MMA(0, 0, At, B0); PG8_MMA(0, 1, At, B1); PG8_BAR; PG8_SCHED;
            PG8_LDA(At, 0, 1); PG8_STAGE(PG8_SB(0, 0), b2, voffB); PG8_STAGE(PG8_SB(0, 1), b2 + hstep, voffB); PG8_STAGE(PG8_SA(0, 0), a2, voffA);
            PG8_WAIT_V(8); PG8_WAIT_L(0); PG8_BAR; PG8_MMA(1, 0, At, B0); PG8_MMA(1, 1, At, B1); PG8_BAR; PG8_SCHED;
            PG8_LDB(B0, 1, 0); PG8_LDB(B1, 1, 1); PG8_SCHED; PG8_LDA(At, 1, 0); PG8_STAGE(PG8_SA(0, 1), a2 + hstep, voffA);
            PG8_WAIT_V(8); PG8_WAIT_L(0); PG8_BAR; PG8_MMA(0, 0, At, B0); PG8_MMA(0, 1, At, B1); PG8_BAR; PG8_SCHED;
            PG8_LDA(At, 1, 1); PG8_STAGE(PG8_SB(1, 0), b3, voffB); PG8_STAGE(PG8_SB(1, 1), b3 + hstep, voffB); PG8_STAGE(PG8_SA(1, 0), a3, voffA);
            PG8_WAIT_V(8); PG8_WAIT_L(0); PG8_BAR; PG8_MMA(1, 0, At, B0); PG8_MMA(1, 1, At, B1); PG8_BAR; PG8_SCHED;
            } else {
            PG8_LDB(B0, 0, 0); PG8_SCHED; PG8_LDA(At, 0, 0); PG8_STAGE(PG8_SA(1, 1), a1 + hstep, voffA);
            PG8_WAIT_L(8); PG8_BAR; PG8_WAIT_L(0); PG8_MMA(0, 0, At, B0); PG8_BAR; PG8_SCHED;
            PG8_LDB(B1, 0, 1); PG8_STAGE(PG8_SB(0, 0), b2, voffB);
            PG8_BAR; PG8_WAIT_L(0); PG8_MMA(0, 1, At, B1); PG8_BAR;
            PG8_LDA(At, 0, 1); PG8_STAGE(PG8_SA(0, 0), a2, voffA);
            PG8_BAR; PG8_WAIT_L(0); PG8_MMA(1, 0, At, B0); PG8_BAR; PG8_SCHED;
            PG8_STAGE(PG8_SB(0, 1), b2 + hstep, voffB);
            PG8_WAIT_V(6); PG8_BAR; PG8_MMA(1, 1, At, B1); PG8_BAR;
            PG8_LDB(B0, 1, 0); PG8_SCHED; PG8_LDA(At, 1, 0); PG8_STAGE(PG8_SA(0, 1), a2 + hstep, voffA);
            PG8_WAIT_L(8); PG8_BAR; PG8_WAIT_L(0); PG8_MMA(0, 0, At, B0); PG8_BAR; PG8_SCHED;
            PG8_LDB(B1, 1, 1); PG8_STAGE(PG8_SB(1, 0), b3, voffB);
            PG8_BAR; PG8_WAIT_L(0); PG8_MMA(0, 1, At, B1); PG8_BAR;
            PG8_LDA(At, 1, 1); PG8_STAGE(PG8_SA(1, 0), a3, voffA);
            PG8_BAR; PG8_WAIT_L(0); PG8_MMA(1, 0, At, B0); PG8_BAR; PG8_SCHED;
            PG8_STAGE(PG8_SB(1, 1), b3 + hstep, voffB);
            PG8_WAIT_V(6); PG8_BAR; PG8_MMA(1, 1, At, B1); PG8_BAR;
            }
        }
        if constexpr (ALIGN_EPI) { if (wr == 0) PG8_BAR; }
        if constexpr (!Epi::AFTER_DRAIN) { E(acc, cur, wr, wc, fr, fq); S.done(cur); }
        if (!has_next) break;
#pragma unroll
        for (int a = 0; a < 2; ++a)
#pragma unroll
            for (int b = 0; b < 2; ++b)
#pragma unroll
                for (int m = 0; m < 4; ++m)
#pragma unroll
                    for (int n = 0; n < 2; ++n) { double z0_, z1_; asm volatile("v_mov_b64 %0, 0\n\tv_mov_b64 %1, 0" : "=v"(z0_), "=v"(z1_)); typedef double f64x2_ __attribute__((ext_vector_type(2))); acc[a][b][m][n] = __builtin_bit_cast(f32x4, (f64x2_){z0_, z1_}); }
        cur = nxt; cA = nA; cB = nB; ++ui;
        if constexpr (ALIGN_EPI) { if (wr == 1) PG8_BAR; }
    }
    PG8_WAIT_V(0);
    if constexpr (!ALIGN_EPI) { if (wr == 0) PG8_BAR; }
    PG8_BAR;
    if constexpr (Epi::AFTER_DRAIN) { E.fused(acc, cur, wr, wc, fr, fq, lds, wid, lane); S.done(cur); }
#undef PG8_SA
#undef PG8_SB
#undef PG8_STAGE
#undef PG8_LDA
#undef PG8_LDB
#undef PG8_MMA
#undef PG8_WAIT_V
#undef PG8_WAIT_L
#undef PG8_BAR
#undef PG8_SCHED
}
}

constexpr int NWAVES = 8;
constexpr int BATCH = 2, SEQ = 8192, DM = 2048, DFF = 5504, HD = 128;
constexpr int M = BATCH * SEQ;
constexpr int NQKV = 3 * DM, NKV = 2 * DM, NWI = 2 * DFF;
constexpr float EPS = 1e-6f;
constexpr float ATT_SCALE = 0.08838834764831845f;

constexpr size_t MiB = 1u << 20;
constexpr size_t WS_CTL = 0, CTL_ZERO_BYTES = 1 * MiB;
constexpr size_t SZ_WI = (size_t)NWI * DM * 2, SZ_WO = (size_t)DM * DFF * 2;
constexpr size_t WS_WI_PRE = 2 * MiB, WS_WI_POST = WS_WI_PRE + 4 * SZ_WI, WS_WO_PRE = WS_WI_POST + 4 * SZ_WI, WS_WO_POST = WS_WO_PRE + 4 * SZ_WO;
constexpr size_t WS_AWQKV = WS_WO_POST + 4 * SZ_WO, SZ_AWQKV = (size_t)NQKV * DM * 2;
constexpr size_t WS_AWO = WS_AWQKV + 2 * SZ_AWQKV, SZ_DD = (size_t)DM * DM * 2;
constexpr size_t WS_BWKV = WS_AWO + 2 * SZ_DD, WS_BWQ = WS_BWKV + 2 * SZ_DD, WS_BWO = WS_BWQ + 2 * SZ_DD;
constexpr size_t WS_LUT = WS_BWO + 2 * SZ_DD;
constexpr size_t WS_XN = WS_LUT + 1 * MiB, SZ_MD = (size_t)M * DM * 2;
constexpr size_t WS_OB = WS_XN + SZ_MD;
constexpr size_t WS_H = WS_OB + SZ_MD, SZ_H = (size_t)M * DFF * 2;
constexpr size_t WS_QKV = WS_H + SZ_H, SZ_QKV = (size_t)M * NQKV * 2;
constexpr size_t WS_KVSH = WS_QKV + SZ_QKV, SZ_KVSH = (size_t)M * NKV * 2;
constexpr size_t WS_SS = WS_KVSH + SZ_KVSH, SZ_SS = (size_t)M * 32 * 4;
constexpr size_t WS_END = WS_SS + 13 * SZ_SS;
constexpr int CW_TMO = 0, CW_CODE = 1;
constexpr int CW_BAR = 4096;
constexpr int RING_OFF = 0, RING_BYTES = 131072;
constexpr int LDSCTL_OFF = RING_BYTES, MISC_OFF = LDSCTL_OFF + 320;
constexpr int QKG_OFF = LDSCTL_OFF + 512, QKX_OFF = QKG_OFF + 1024;
constexpr int RSTD_OFF = QKX_OFF + 8192;
constexpr int LDS_BYTES = 155648;
static_assert(MISC_OFF + 128 <= QKG_OFF && RSTD_OFF + 11 * 1024 <= LDS_BYTES && LDS_BYTES <= 163840, "LDS map");

#define GAS __attribute__((address_space(1)))
#define LAS __attribute__((address_space(3)))
typedef unsigned short bf16;
typedef unsigned v4u __attribute__((ext_vector_type(4)));
typedef float f32x4 __attribute__((ext_vector_type(4)));
typedef short bf16x8 __attribute__((ext_vector_type(8)));
typedef GAS unsigned gu32;
typedef GAS unsigned long long gu64;
#define RLX_AGENT __ATOMIC_RELAXED, __HIP_MEMORY_SCOPE_AGENT
#define LDS_WAIT() asm volatile("s_waitcnt lgkmcnt(0)" ::: "memory")
#define VM_WAIT() asm volatile("s_waitcnt vmcnt(0)" ::: "memory")
__device__ __forceinline__ unsigned long long rt() { return __builtin_amdgcn_s_memrealtime(); }
__device__ __forceinline__ unsigned f2bf(float f) { unsigned u = __builtin_bit_cast(unsigned, f); return (u + 0x7fffu + ((u >> 16) & 1u)) >> 16; }
__device__ __forceinline__ unsigned pk2(float lo, float hi) { return f2bf(lo) | (f2bf(hi) << 16); }

#define XB_TMO      128
#define XB_XCNT(j)  (256  + 64 * (j))
#define XB_XSUB(j)  (1280 + 64 * (j))
#define XB_XGEN(j)  (2304 + 64 * (j))
#define XB_TOP      3328
#define XB_TOPGEN   3392
#define XCD_BAR_WORDS 3456
#define XB_SPIN_CAP (1u << 18)

__device__ __forceinline__ unsigned xb_ld(unsigned* p)              { return __hip_atomic_load(p, __ATOMIC_RELAXED, __HIP_MEMORY_SCOPE_AGENT); }
__device__ __forceinline__ unsigned xb_add(unsigned* p, unsigned v) { return __hip_atomic_fetch_add(p, v, __ATOMIC_RELAXED, __HIP_MEMORY_SCOPE_AGENT); }
__device__ __forceinline__ unsigned xb_xcc_id() { return (unsigned)__builtin_amdgcn_s_getreg((3 << 11) | 20) & 0xFu; }
#define XB_SPIN(cond, bar) do { unsigned _sp = 0; while (cond) { __builtin_amdgcn_s_sleep(1); \
    if ((++_sp & 255u) == 0u) { if (xb_ld(&(bar)[XB_TMO])) break; if (_sp > XB_SPIN_CAP) { atomicAdd(&(bar)[XB_TMO], 1u); break; } } } } while (0)

struct XcdBarrier {
    unsigned* bar; unsigned x; int tid;
    volatile LAS unsigned* st;
};

__device__ __forceinline__ XcdBarrier xcd_barrier_post(unsigned* bar, volatile LAS unsigned* st) {
    XcdBarrier b; b.bar = bar; b.x = xb_xcc_id(); b.st = st; b.tid = (int)threadIdx.x;
    if (threadIdx.x == 0) (void)xb_add(&bar[XB_XCNT(b.x)], 1u);
    return b;
}
__device__ __forceinline__ void xcd_barrier_complete(unsigned* bar, unsigned x, unsigned& nloc, unsigned& nx) {
    const unsigned G = gridDim.x * gridDim.y * gridDim.z;
    unsigned sum, cnt, mine, sp = 0u;
    for (;;) {
        sum = 0u; cnt = 0u; mine = 0u;
#pragma unroll
        for (unsigned j = 0; j < 16; ++j) { const unsigned c = xb_ld(&bar[XB_XCNT(j)]); sum += c; cnt += (c > 0u) ? 1u : 0u; mine = (j == x) ? c : mine; }
        if (sum == G) break;
        __builtin_amdgcn_s_sleep(1);
        if ((++sp & 255u) == 0u) { if (xb_ld(&bar[XB_TMO])) break; if (sp > XB_SPIN_CAP) { atomicAdd(&bar[XB_TMO], 1u); break; } }
    }
    nloc = mine > 0u ? mine : 1u; nx = cnt > 0u ? cnt : 1u;
}

__device__ __forceinline__ void xcd_barrier(const XcdBarrier& b) {
    asm volatile("s_waitcnt vmcnt(0)" ::: "memory");
    __syncthreads();
    int tid0_ = b.tid; asm volatile("" : "+v"(tid0_));
    if (tid0_ == 0) {
        unsigned* bar = b.bar;
        __builtin_amdgcn_s_waitcnt(0);
        unsigned nloc = b.st[0], nx = b.st[1];
        if (nloc == 0u) { xcd_barrier_complete(bar, b.x, nloc, nx); b.st[0] = nloc; b.st[1] = nx; }
        const unsigned old = xb_add(&bar[XB_XSUB(b.x)], 1u);
        const unsigned gen = old / nloc;
        if (old + 1u == (gen + 1u) * nloc) {
            __builtin_amdgcn_fence(__ATOMIC_RELEASE, "agent");
            asm volatile("s_waitcnt vmcnt(0)" ::: "memory");
            const unsigned og = xb_add(&bar[XB_TOP], 1u);
            const unsigned tg = og / nx;
            if (og + 1u == (tg + 1u) * nx) xb_add(&bar[XB_TOPGEN], 1u);
            else XB_SPIN(xb_ld(&bar[XB_TOPGEN]) == tg, bar);
            __builtin_amdgcn_fence(__ATOMIC_ACQUIRE, "agent");
            xb_add(&bar[XB_XGEN(b.x)], 1u);
            asm volatile("s_waitcnt vmcnt(0)" ::: "memory");
        } else {
            XB_SPIN(xb_ld(&bar[XB_XGEN(b.x)]) == gen, bar);
            __builtin_amdgcn_fence(__ATOMIC_ACQUIRE, "agent");
            asm volatile("s_waitcnt vmcnt(0)" ::: "memory");
        }
    }
    __syncthreads();
}

struct Args { const float* in[19]; float* out; unsigned char* ws; };
__device__ __forceinline__ int launder_v(int v) { asm volatile("" : "+v"(v)); return v; }
#define CUR_TID(F) (((F).wave << 6) | lane_id())
struct Frame {
    LAS unsigned char* lds;
    volatile LAS unsigned* MISC;
    gu32* ctl;
    int wave;
    int vcu, G;
};
__device__ __forceinline__ float wave_sum(float v) {
#pragma unroll
    for (int o = 1; o < 64; o <<= 1) v += shx(v, o);
    return v;
}
__device__ __forceinline__ float wave_max(float v) {
#pragma unroll
    for (int o = 1; o < 64; o <<= 1) v = fmaxf(v, shx(v, o));
    return v;
}
__device__ __forceinline__ float bf2f(unsigned short h) { return __uint_as_float((unsigned)h << 16); }
__device__ __forceinline__ float bflo(unsigned w) { return __uint_as_float(w << 16); }
__device__ __forceinline__ float bfhi(unsigned w) { return __uint_as_float(w & 0xffff0000u); }

__device__ __forceinline__ int t5_bucket(int n) {
    if (n < 16) return n;
    if (n >= 113) return 31;
    int b = 16;
    b += (n >= 19); b += (n >= 21); b += (n >= 24); b += (n >= 27); b += (n >= 31); b += (n >= 35); b += (n >= 40); b += (n >= 46);
    b += (n >= 52); b += (n >= 59); b += (n >= 67); b += (n >= 77); b += (n >= 87); b += (n >= 99);
    return b;
}

template <bool GLU>
__device__ __forceinline__ void transpose_group(Frame& F, int part, int nparts, const float* W, const float* gain, int L, int K, int N, bf16* WT, LAS float* scr, float wscale = 1.0f) {
    int gw = part * NWAVES + F.wave; asm volatile("" : "+s"(gw)); const int NGW = nparts * NWAVES; const int lane = lane_id();
    const int nblk = N / 32, kblk = K / 64, per = nblk * kblk, total = L * per;
    const int c = lane & 7, lr = lane >> 3;
    f32x4 v[8], g0 = {1.f, 1.f, 1.f, 1.f}, g1 = g0;
#define TG_DECODE(it_) const int l_ = (it_) / per, r_ = (it_) - l_ * per, kb_ = r_ / nblk, nb_ = r_ - kb_ * nblk, n0_ = nb_ * 32, k0_ = kb_ * 64; const size_t lo_ = (size_t)l_ * K * N;
#define TG_LOAD(it_) do { TG_DECODE(it_); const float* w_ = W + lo_ + (size_t)(k0_ + lr) * N + n0_ + 4 * c;                                                   \
        _Pragma("unroll") for (int i = 0; i < 8; ++i) v[i] = *(const GAS f32x4*)(w_ + (size_t)(8 * i) * N);                                                    \
        if (gain) { const float* g_ = gain + (size_t)l_ * K + k0_ + 8 * c; g0 = *(const GAS f32x4*)g_; g1 = *(const GAS f32x4*)(g_ + 4); } } while (0)
    if (gw < total) TG_LOAD(gw);
    for (int it = gw; it < total; it += NGW) {
#pragma unroll
        for (int i = 0; i < 8; ++i) { LAS float* d = scr + (8 * i + lr) * 33 + 4 * c; d[0] = v[i].x; d[1] = v[i].y; d[2] = v[i].z; d[3] = v[i].w; }
        const f32x4 h0 = g0 * wscale, h1 = g1 * wscale;
        LDS_WAIT(); asm volatile("" ::: "memory");
        if (it + NGW < total) TG_LOAD(it + NGW);
        TG_DECODE(it);
        int drow0 = n0_;
        if (GLU) { const int half = N / 2; const int cc = n0_ >= half ? n0_ - half : n0_; drow0 = (cc >> 7) * 256 + (n0_ >= half ? 128 : 0) + (cc & 127); }
        bf16* wt_ = WT + lo_ + (size_t)drow0 * K + k0_ + 8 * c;
#pragma unroll
        for (int j = 0; j < 4; ++j) { const int n = lr + 8 * j; const LAS float* s = scr + (8 * c) * 33 + n;
            v4u o; o.x = pg8::cvt_pk_bf16(s[0 * 33] * h0.x, s[1 * 33] * h0.y); o.y = pg8::cvt_pk_bf16(s[2 * 33] * h0.z, s[3 * 33] * h0.w); o.z = pg8::cvt_pk_bf16(s[4 * 33] * h1.x, s[5 * 33] * h1.y); o.w = pg8::cvt_pk_bf16(s[6 * 33] * h1.z, s[7 * 33] * h1.w);
            *(GAS v4u*)(wt_ + (size_t)n * K) = o; }
        LDS_WAIT(); asm volatile("" ::: "memory");
    }
#undef TG_LOAD
#undef TG_DECODE
}
__device__ __forceinline__ void cast_rows(Frame& F, const float* x, bf16* xb, float* ss) {
    int gw = F.vcu * NWAVES + F.wave; asm volatile("" : "+s"(gw)); const int NGW = F.G * NWAVES; const int lane = lane_id();
    for (int m = gw; m < M; m += NGW) {
        const GAS f32x4* xr = (const GAS f32x4*)(x + (size_t)m * DM) + lane;
        f32x4 v[8]; float s = 0.f;
#pragma unroll
        for (int j = 0; j < 8; ++j) { v[j] = xr[64 * j]; s += (v[j].x * v[j].x + v[j].y * v[j].y) + (v[j].z * v[j].z + v[j].w * v[j].w); }
        s = wave_sum(s);
        GAS unsigned long long* o8 = (GAS unsigned long long*)(xb + (size_t)m * DM) + lane;
#pragma unroll
        for (int j = 0; j < 8; ++j) o8[64 * j] = (unsigned long long)pk2(v[j].x, v[j].y) | ((unsigned long long)pk2(v[j].z, v[j].w) << 32);
        if (lane < 32) ss[(size_t)m * 32 + lane] = lane == 0 ? s : 0.f;
    }
}
namespace att {
typedef short s16x4 __attribute__((ext_vector_type(4)));
typedef float f32x16 __attribute__((ext_vector_type(16)));
typedef unsigned u32x4 __attribute__((ext_vector_type(4)));
constexpr int NW = 8, QBLK = 32, KVBLK = 64, QB = NW * QBLK, D = 128;
constexpr int SHM_V = KVBLK * D * 2, SHM_K = KVBLK * D * 2;
constexpr int LDS_WS = 2 * SHM_V + 2 * SHM_K;
constexpr float SCALE = 0.08838834764831845f;
#define KSWZ(row, colB) ((row) * 256 + ((colB) ^ (((row) & 7) << 4)))
#define SBAR() __builtin_amdgcn_sched_barrier(0)
__device__ __forceinline__ int v_st(int k, int c) { const int kk = (k & ~0xC) | ((k & 4) << 1) | ((k & 8) >> 1); return ((kk >> 3) * 4 + (c >> 5)) * 512 + ((kk & 7) * 32 + (c & 31)) * 2; }
__device__ __forceinline__ int v_rd_base(int lane) { return ((lane & 3) << 3) | (((lane >> 2) & 3) << 6) | (((lane >> 4) & 1) << 5) | (((lane >> 5) & 1) << 8); }
constexpr int v_rd_off(int d0, int ks, int half) { return d0 * 512 + ks * 4096 + half * 2048; }
__device__ __forceinline__ int crow(int r, int hi) { return (r & 3) + 8 * (r >> 2) + 4 * hi; }
__device__ __forceinline__ unsigned cvtpk(float lo, float hi) { unsigned r; asm volatile("v_cvt_pk_bf16_f32 %0, %1, %2" : "=v"(r) : "v"(lo), "v"(hi)); return r; }
__device__ __forceinline__ bf16x8 load8(const bf16* p) { return *reinterpret_cast<const bf16x8*>(p); }

#define PK4(P, B_, OUT) do { unsigned a0 = cvtpk(P[B_+0], P[B_+1]), a1 = cvtpk(P[B_+2], P[B_+3]);                          \
        unsigned b0 = cvtpk(P[B_+4], P[B_+5]), b1 = cvtpk(P[B_+6], P[B_+7]);                                             \
        auto r0 = __builtin_amdgcn_permlane32_swap(a0, b0, false, false); auto r1 = __builtin_amdgcn_permlane32_swap(a1, b1, false, false); \
        u32x4 w = {r0[0], r1[0], r0[1], r1[1]}; OUT = *reinterpret_cast<bf16x8*>(&w); } while (0)
template <int KB>
__device__ __forceinline__ void qkt(f32x16& p0, f32x16& p1, const char* K_lds, int r32, int hi, const bf16x8* qr) {
    p0 = f32x16{}; p1 = f32x16{};
    const char* kb[4];
#pragma unroll
    for (int dd = 0; dd < 4; ++dd) kb[dd] = K_lds + KB * SHM_K + KSWZ(r32, (dd * 16 + hi * 8) * 2);
#pragma unroll
    for (int d0 = 0; d0 < 8; ++d0) { const char* a = kb[d0 & 3] + (d0 >> 2) * 128;
        bf16x8 b0 = *reinterpret_cast<const bf16x8*>(a);
        bf16x8 b1 = *reinterpret_cast<const bf16x8*>(a + 32 * 256);
        p0 = __builtin_amdgcn_mfma_f32_32x32x16_bf16(b0, qr[d0], p0, 0, 0, 0);
        p1 = __builtin_amdgcn_mfma_f32_32x32x16_bf16(b1, qr[d0], p1, 0, 0, 0); }
}
template <int VB>
__device__ __forceinline__ void pv_tile(f32x16* o, int vb0, bf16x8 pa0, bf16x8 pa1, bf16x8 pa2, bf16x8 pa3) {
#define TRRD(dst, off) asm volatile("ds_read_b64_tr_b16 %0, %1 offset:%2" : "=&v"(dst) : "v"(vb0), "i"(off) : "memory")
#define PV_D0(d0) do { s16x4 l0, l1, l2, l3, h0, h1, h2, h3; constexpr int b_ = VB * SHM_V + v_rd_off(d0, 0, 0);   \
        TRRD(l0, b_); TRRD(h0, b_ + 2048); TRRD(l1, b_ + 4096); TRRD(h1, b_ + 6144); TRRD(l2, b_ + 8192); TRRD(h2, b_ + 10240); TRRD(l3, b_ + 12288); TRRD(h3, b_ + 14336); \
        asm volatile("s_waitcnt lgkmcnt(0)" ::: "memory"); SBAR();   \
        o[d0] = __builtin_amdgcn_mfma_f32_32x32x16_bf16(pa0, (bf16x8){l0[0], l0[1], l0[2], l0[3], h0[0], h0[1], h0[2], h0[3]}, o[d0], 0, 0, 0);   \
        o[d0] = __builtin_amdgcn_mfma_f32_32x32x16_bf16(pa1, (bf16x8){l1[0], l1[1], l1[2], l1[3], h1[0], h1[1], h1[2], h1[3]}, o[d0], 0, 0, 0);   \
        o[d0] = __builtin_amdgcn_mfma_f32_32x32x16_bf16(pa2, (bf16x8){l2[0], l2[1], l2[2], l2[3], h2[0], h2[1], h2[2], h2[3]}, o[d0], 0, 0, 0);   \
        o[d0] = __builtin_amdgcn_mfma_f32_32x32x16_bf16(pa3, (bf16x8){l3[0], l3[1], l3[2], l3[3], h3[0], h3[1], h3[2], h3[3]}, o[d0], 0, 0, 0); } while (0)
    PV_D0(0); PV_D0(1); PV_D0(2); PV_D0(3);
#undef PV_D0
#undef TRRD
}

struct BlockRef { const bf16* Q; const bf16* K; const bf16* V; bf16* O; int P0; };
struct Seam { bf16x8 qr[8]; bf16x8 st_v0, st_v1, st_k0, st_k1; };
#define LD16(base, boff) (*(const bf16x8*)((const char*)(base) + (size_t)(boff) + loff))
#define VMW() asm volatile("s_waitcnt vmcnt(0)" ::: "memory")
#define SLOAD_H(Kp, Vp, k0) do { const size_t ko_ = (size_t)(k0) * KS * 2; S.st_v0 = LD16(Vp, ko_); S.st_v1 = LD16(Vp, ko_ + 32 * VS * 2);              \
                         S.st_k0 = LD16(Kp, ko_); S.st_k1 = LD16(Kp, ko_ + 32 * KS * 2); } while (0)
#define SWRITE_HK(bf) do { *(bf16x8*)(K_lds + (bf) * SHM_K + kws) = S.st_k0; *(bf16x8*)(K_lds + (bf) * SHM_K + kws + 32 * 256) = S.st_k1; } while (0)
#define SWRITE_HV(bf) do { *(bf16x8*)(V_lds + (bf) * SHM_V + vst0) = S.st_v0; *(bf16x8*)(V_lds + (bf) * SHM_V + vst1) = S.st_v1; } while (0)
#define SWRITE_H(bf) do { SWRITE_HV(bf); SWRITE_HK(bf); } while (0)

__device__ __forceinline__ void sb_weights(f32x16& p0, f32x16& p1, int dq, bool need_mask, int hi, float& C, bf16x8& pa0, bf16x8& pa1, bf16x8& pa2, bf16x8& pa3) {
    float qs[8], osi[9];
#pragma unroll
    for (int g = 0; g < 8; ++g) {
        float lk[4], y[4];
#pragma unroll
        for (int i = 0; i < 4; ++i) {
            y[i] = g < 4 ? p0[4 * g + i] : p1[4 * (g - 4) + i];
            const float sp = fmaxf(y[i], 0.f) + __builtin_amdgcn_logf(1.0f + __builtin_amdgcn_exp2f(-fabsf(y[i])));
            const int c = i + 8 * g;
            const bool valid = !need_mask || (dq - c > 0);
            lk[i] = valid ? -sp : 0.f;
            y[i] = valid ? y[i] : -__builtin_inff();
        }
        const float s2 = lk[3], s1 = s2 + lk[2], s0 = s1 + lk[1];
        qs[g] = s0 + lk[0];
        const float e0 = y[0] + lk[0] + s0, e1 = y[1] + lk[1] + s1, e2 = y[2] + lk[2] + s2, e3 = y[3] + lk[3];
        if (g < 4) { p0[4 * g] = e0; p0[4 * g + 1] = e1; p0[4 * g + 2] = e2; p0[4 * g + 3] = e3; }
        else { p1[4 * (g - 4)] = e0; p1[4 * (g - 4) + 1] = e1; p1[4 * (g - 4) + 2] = e2; p1[4 * (g - 4) + 3] = e3; }
    }
    osi[8] = 0.f;
#pragma unroll
    for (int g = 7; g >= 0; --g) osi[g] = qs[g] + osi[g + 1];
    float tot;
    { auto rr = __builtin_amdgcn_permlane32_swap(__float_as_uint(osi[0]), __float_as_uint(osi[0]), false, false); tot = __uint_as_float(rr[0]) + __uint_as_float(rr[1]); }
#pragma unroll
    for (int g = 0; g < 8; ++g) {
        auto rr = __builtin_amdgcn_permlane32_swap(__float_as_uint(osi[g]), __float_as_uint(osi[g + 1]), false, false);
        const float T = osi[g + 1] + (hi ? __uint_as_float(rr[0]) : __uint_as_float(rr[1])) + C;
#pragma unroll
        for (int i = 0; i < 4; ++i) {
            if (g < 4) p0[4 * g + i] = __builtin_amdgcn_exp2f(p0[4 * g + i] + T); else p1[4 * (g - 4) + i] = __builtin_amdgcn_exp2f(p1[4 * (g - 4) + i] + T);
        }
    }
    C += tot;
    PK4(p0, 0, pa0); PK4(p0, 8, pa1); PK4(p1, 0, pa2); PK4(p1, 8, pa3);
}
template <int QS, int KS, int VS, int OS, bool EXIT>
__device__ __forceinline__ void sb_block(const BlockRef& cur, char* lds, int tid) {
    static_assert(KS == VS, "one lane offset serves K and V");
    const int wid = __builtin_amdgcn_readfirstlane(tid >> 6), lane = tid & 63, r32 = lane & 31, hi = lane >> 5;
    const int NT = cur.P0 / KVBLK + 4;
    const int qlo = cur.P0 + wid * QBLK, qm = qlo + r32 - 4 * hi;
    char* V_lds = lds; char* K_lds = lds + 2 * SHM_V;
    volatile LAS unsigned* flags = (volatile LAS unsigned*)(uintptr_t)((unsigned)(uintptr_t)lds + LDS_WS);
    const int sr = tid >> 4, sc = (tid & 15) * 8, vst0 = v_st(sr, sc), vst1 = v_st(32 + sr, sc), kws = KSWZ(sr, sc * 2);
    const unsigned loff = (unsigned)(sr * KS + sc) * 2u, qoff = (unsigned)(r32 * QS + hi * 8) * 2u;
    const int vb0 = (int)(uintptr_t)V_lds + v_rd_base(lane);
    Seam S;
#pragma unroll
    for (int d0 = 0; d0 < 8; ++d0) S.qr[d0] = *(const bf16x8*)((const char*)cur.Q + (size_t)(wid * QBLK) * QS * 2 + d0 * 32 + qoff);
#define KBASE(t) ((NT - 1 - (t)) * KVBLK)
    SLOAD_H(cur.K, cur.V, KBASE(0)); VMW(); SWRITE_H(0);
    SLOAD_H(cur.K, cur.V, KBASE(1));
    __syncthreads();
    f32x16 o[4] = {}; float C = 0.f; f32x16 p0, p1; bf16x8 pa0, pa1, pa2, pa3;
    bool wdone = false;
#define SB_STEP(t, B) do {                                                                                       \
        { const int kb_ = KBASE(t);                                                                               \
          if (!wdone && kb_ < qlo + QBLK) {                  \
            SBAR(); qkt<B>(p0, p1, K_lds, r32, hi, S.qr);                                                          \
            sb_weights(p0, p1, qm - kb_, kb_ + KVBLK > qlo, hi, C, pa0, pa1, pa2, pa3);                            \
            SBAR(); pv_tile<B>(o, vb0, pa0, pa1, pa2, pa3);                                                        \
            if (EXIT) wdone = __all(C < -160.f); } }                                                              \
        if (EXIT) { if (lane == 0) flags[((t) & 1) * 8 + wid] = wdone ? 1u : 0u; }                                 \
        if ((t) + 1 < NT) { VMW(); SWRITE_H((B) ^ 1); if ((t) + 2 < NT) SLOAD_H(cur.K, cur.V, KBASE((t) + 2)); }  \
        __syncthreads(); } while (0)
    for (int t = 0; t < NT; t += 2) {
        SB_STEP(t, 0);
        SB_STEP(t + 1, 1);
        if (EXIT) { unsigned a = 1u;
#pragma unroll
            for (int w = 0; w < 8; ++w) a &= flags[8 + w];
            if (a) break; }
    }
    VMW();
    char* Ow = (char*)cur.O + (size_t)(wid * QBLK) * OS * 2; const unsigned ooff = (unsigned)(4 * hi * OS + r32) * 2u;
#pragma unroll
    for (int r = 0; r < 16; ++r) { const int orow0 = (r & 3) + 8 * (r >> 2);
#pragma unroll
        for (int d0 = 0; d0 < 4; ++d0) { const float v = o[d0][r];
            const float vn = shx(v, 1);
            if ((r32 & 1) == 0) *(unsigned*)(Ow + (size_t)(orow0 * OS + d0 * 32) * 2 + ooff) = cvtpk(v, vn); } }
    __syncthreads();
#undef KBASE
#undef SB_STEP
}
}
namespace att2 {
using att::f32x16; using att::s16x4; using att::u32x4; using att::cvtpk; using att::crow;
constexpr int STG = 32768, K2_OFF = 8192, V_OFF = 16384;
constexpr int LDS_WS = 131072 + 512, LDS_LUT = LDS_WS + 2048, LDS_END = LDS_LUT + 2 * 272 * 4;
constexpr float SCALE = att::SCALE, C2 = 1.4426950408889634f * SCALE;
#define SBAR() __builtin_amdgcn_sched_barrier(0)
#define A2_WAITV(n) asm volatile("s_waitcnt vmcnt(" #n ")" ::: "memory")
#define A2_BAR() do { asm volatile("s_waitcnt lgkmcnt(0)" ::: "memory"); __builtin_amdgcn_s_barrier(); asm volatile("" ::: "memory"); } while (0)
__device__ __forceinline__ void bias_mask16(f32x16& p, int dq, const LAS float* lut) {
    const float NEG = -__builtin_inff();
    const LAS float* lp = lut + 64 + dq;
#pragma unroll
    for (int r = 0; r < 16; ++r) { const int c = (r & 3) + 8 * (r >> 2); p[r] = (dq - c >= 0) ? p[r] + lp[-c] : NEG; }
}
__device__ __forceinline__ void partialSM16(f32x16& p, float& m_reg, float& alpha, float bo) {
    constexpr float THR = 8.f;
    float pmax = p[0];
#pragma unroll
    for (int r = 1; r < 16; ++r) pmax = fmaxf(pmax, p[r]);
    { auto rr = __builtin_amdgcn_permlane32_swap(__float_as_uint(pmax), __float_as_uint(pmax), false, false); pmax = fmaxf(__uint_as_float(rr[0]), __uint_as_float(rr[1])); }
    pmax += bo;
    float mn;
    if (__builtin_expect(__all((pmax - m_reg) * SCALE <= THR), 1)) { mn = m_reg; alpha = 1.f; }
    else { mn = fmaxf(m_reg, pmax); alpha = __builtin_amdgcn_exp2f((m_reg - mn) * C2); m_reg = mn; }
    const float mnL = (bo - mn) * C2;
#pragma unroll
    for (int r = 0; r < 16; ++r) p[r] = fmaf(p[r], C2, mnL);
}
__device__ __forceinline__ void finishSM16(f32x16& p, float alpha, float& l_reg, bf16x8& pa0, bf16x8& pa1) {
#pragma unroll
    for (int r = 0; r < 16; ++r) p[r] = __builtin_amdgcn_exp2f(p[r]);
    float ps = 0.f;
#pragma unroll
    for (int r = 0; r < 16; ++r) ps += p[r];
    { auto rr = __builtin_amdgcn_permlane32_swap(__float_as_uint(ps), __float_as_uint(ps), false, false); ps = __uint_as_float(rr[0]) + __uint_as_float(rr[1]); }
    l_reg = l_reg * alpha + ps;
    PK4(p, 0, pa0); PK4(p, 8, pa1);
}
#define KRD(dst, addr, off) asm volatile("ds_read_b128 %0, %1 offset:%2" : "=&v"(dst) : "v"(addr), "i"(off) : "memory")
#define KWAIT(n, dst) asm volatile("s_waitcnt lgkmcnt(" #n ")" : "+v"(dst) :: "memory")
__device__ __forceinline__ void qkt16_exp(f32x16& px, f32x16& py, int kb, const int (&kofs)[4], const bf16x8* qr) {
    bf16x8 k0, k1;
    KRD(k0, kb + kofs[0], 0); KRD(k1, kb + kofs[1], 0);
    px = f32x16{};
#define EX2(i) do { py[2 * (i)] = __builtin_amdgcn_exp2f(py[2 * (i)]); py[2 * (i) + 1] = __builtin_amdgcn_exp2f(py[2 * (i) + 1]); } while (0)
    KWAIT(1, k0); px = __builtin_amdgcn_mfma_f32_32x32x16_bf16(k0, qr[0], px, 0, 0, 0); KRD(k0, kb + kofs[2], 0);   EX2(0); SBAR();
    KWAIT(1, k1); px = __builtin_amdgcn_mfma_f32_32x32x16_bf16(k1, qr[1], px, 0, 0, 0); KRD(k1, kb + kofs[3], 0);   EX2(1); SBAR();
    KWAIT(1, k0); px = __builtin_amdgcn_mfma_f32_32x32x16_bf16(k0, qr[2], px, 0, 0, 0); KRD(k0, kb + kofs[0], 128); EX2(2); SBAR();
    KWAIT(1, k1); px = __builtin_amdgcn_mfma_f32_32x32x16_bf16(k1, qr[3], px, 0, 0, 0); KRD(k1, kb + kofs[1], 128); EX2(3); SBAR();
    KWAIT(1, k0); px = __builtin_amdgcn_mfma_f32_32x32x16_bf16(k0, qr[4], px, 0, 0, 0); KRD(k0, kb + kofs[2], 128); EX2(4); SBAR();
    KWAIT(1, k1); px = __builtin_amdgcn_mfma_f32_32x32x16_bf16(k1, qr[5], px, 0, 0, 0); KRD(k1, kb + kofs[3], 128); EX2(5); SBAR();
    KWAIT(1, k0); px = __builtin_amdgcn_mfma_f32_32x32x16_bf16(k0, qr[6], px, 0, 0, 0); EX2(6); SBAR();
    KWAIT(0, k1); px = __builtin_amdgcn_mfma_f32_32x32x16_bf16(k1, qr[7], px, 0, 0, 0); EX2(7); SBAR();
#undef EX2
}
__device__ __forceinline__ void finish_pack16(f32x16& p, float alpha, float& l_reg, bf16x8& pa0, bf16x8& pa1) {
    float ps = 0.f;
#pragma unroll
    for (int r = 0; r < 16; ++r) ps += p[r];
    { auto rr = __builtin_amdgcn_permlane32_swap(__float_as_uint(ps), __float_as_uint(ps), false, false); ps = __uint_as_float(rr[0]) + __uint_as_float(rr[1]); }
    l_reg = l_reg * alpha + ps;
    PK4(p, 0, pa0); PK4(p, 8, pa1);
}
__device__ __forceinline__ void qkt16(f32x16& p, const char* sb, const int (&kofs)[4], const bf16x8* qr) {
    p = f32x16{};
#pragma unroll
    for (int d0 = 0; d0 < 8; ++d0) { const bf16x8 kf = *reinterpret_cast<const bf16x8*>(sb + kofs[d0 & 3] + (d0 >> 2) * 128);
        p = __builtin_amdgcn_mfma_f32_32x32x16_bf16(kf, qr[d0], p, 0, 0, 0); }
}
__device__ __forceinline__ void pv16(f32x16* o, int vb, bf16x8 pa0, bf16x8 pa1) {
#define TRRD(dst, off) asm volatile("ds_read_b64_tr_b16 %0, %1 offset:%2" : "=&v"(dst) : "v"(vb), "i"(off) : "memory")
#define RD4(S, d0) do { TRRD(S##l0, (d0) * 512); TRRD(S##h0, (d0) * 512 + 4096); TRRD(S##l1, (d0) * 512 + 8192); TRRD(S##h1, (d0) * 512 + 12288); } while (0)
#define MM2(S, d0) do { o[d0] = __builtin_amdgcn_mfma_f32_32x32x16_bf16(pa0, (bf16x8){S##l0[0], S##l0[1], S##l0[2], S##l0[3], S##h0[0], S##h0[1], S##h0[2], S##h0[3]}, o[d0], 0, 0, 0);   \
        o[d0] = __builtin_amdgcn_mfma_f32_32x32x16_bf16(pa1, (bf16x8){S##l1[0], S##l1[1], S##l1[2], S##l1[3], S##h1[0], S##h1[1], S##h1[2], S##h1[3]}, o[d0], 0, 0, 0); } while (0)
#define WAITL(n) asm volatile("s_waitcnt lgkmcnt(" #n ")" ::: "memory")
    s16x4 Al0, Ah0, Al1, Ah1, Bl0, Bh0, Bl1, Bh1;
    RD4(A, 0);
    RD4(B, 1); WAITL(4); SBAR(); MM2(A, 0); SBAR();
    RD4(A, 2); WAITL(4); SBAR(); MM2(B, 1); SBAR();
    RD4(B, 3); WAITL(4); SBAR(); MM2(A, 2); SBAR();
    RD4(A, 4); WAITL(4); SBAR(); MM2(B, 3); SBAR();
    RD4(B, 5); WAITL(4); SBAR(); MM2(A, 4); SBAR();
    RD4(A, 6); WAITL(4); SBAR(); MM2(B, 5); SBAR();
    RD4(B, 7); WAITL(4); SBAR(); MM2(A, 6); SBAR();
    WAITL(0); SBAR(); MM2(B, 7);
#undef RD4
#undef MM2
#undef WAITL
#undef TRRD
}
template <int LD, int OLD>
__device__ __forceinline__ void diff_unit(const bf16* QKVb, bf16* Ob, int h, int P0, LAS unsigned char* ldsl, int tid, float lam, float oml, const float* subln, float bfar) {
    char* lds = (char*)ldsl;
    asm volatile("" : "+v"(tid));
    const int wid = __builtin_amdgcn_readfirstlane(tid >> 6), lane = tid & 63, r32 = lane & 31, hi = lane >> 5, rg = wid & 3, mp = wid >> 2;
    const int qlo = P0 + 32 * rg, qm = qlo + r32 - 4 * hi;
    const int NS = P0 / 32 + 4;
    float* wsf = (float*)(lds + LDS_WS) + wid * 64; float* li_l = wsf, * al_l = wsf + 32;
    const LAS float* lut = (const LAS float*)(ldsl + LDS_LUT) + mp * 272;
    bf16x8 qr[8];
    { const char* qb = (const char*)(QKVb + (size_t)qlo * LD + (2 * h + mp) * 128); const unsigned qoff = (unsigned)(r32 * LD + hi * 8) * 2u;
#pragma unroll
      for (int d0 = 0; d0 < 8; ++d0) qr[d0] = *(const bf16x8*)(qb + d0 * 32 + qoff); }
    unsigned koff, voff;
    { const int r = 4 * wid + (lane >> 4), c = (lane & 15) ^ (r & 7); koff = (unsigned)(r * LD + c * 8) * 2u;
      const int s = 2 * wid + (lane >> 5), kg = s >> 3, cb = s & 7, rr = (lane >> 2) & 7, q = lane & 3, kk = kg * 8 + rr, k = (kk & ~0xC) | ((kk & 4) << 1) | ((kk & 8) >> 1);
      voff = (unsigned)(k * LD + cb * 32 + q * 8) * 2u; }
    const char* Kg = (const char*)(QKVb + 2048 + (2 * h) * 128); const char* Vg = (const char*)(QKVb + 4096 + h * 256);
#define A2_DMA(u) do { if (mp == 0) { const size_t ro_ = (size_t)(u) * 32 * LD * 2; LAS unsigned char* sb_ = ldsl + ((u) & 3) * STG + wid * 1024;                  \
        __builtin_amdgcn_global_load_lds((const unsigned*)(Kg + ro_ + koff), (LAS unsigned*)(sb_), 16, 0, 0);                                                           \
        __builtin_amdgcn_global_load_lds((const unsigned*)(Kg + ro_ + 256 + koff), (LAS unsigned*)(sb_ + K2_OFF), 16, 0, 0);                                            \
        __builtin_amdgcn_global_load_lds((const unsigned*)(Vg + ro_ + voff), (LAS unsigned*)(sb_ + V_OFF), 16, 0, 0);                                                   \
        __builtin_amdgcn_global_load_lds((const unsigned*)(Vg + ro_ + (size_t)16 * LD * 2 + voff), (LAS unsigned*)(sb_ + V_OFF + 8192), 16, 0, 0);                       \
                      \
        __builtin_amdgcn_global_load_lds((const unsigned*)(Kg + ro_ + (size_t)16 * LD * 2 + koff), (LAS unsigned*)(sb_ + 4096), 16, 0, 0);                               \
        __builtin_amdgcn_global_load_lds((const unsigned*)(Kg + ro_ + (size_t)16 * LD * 2 + 256 + koff), (LAS unsigned*)(sb_ + 4096 + K2_OFF), 16, 0, 0);                \
        __builtin_amdgcn_global_load_lds((const unsigned*)(Vg + ro_ + (size_t)4 * LD * 2 + voff), (LAS unsigned*)(sb_ + 4096 + V_OFF), 16, 0, 0);                        \
        __builtin_amdgcn_global_load_lds((const unsigned*)(Vg + ro_ + (size_t)20 * LD * 2 + voff), (LAS unsigned*)(sb_ + 4096 + V_OFF + 8192), 16, 0, 0); } } while (0)
    int kofs[4];
#pragma unroll
    for (int dd = 0; dd < 4; ++dd) kofs[dd] = mp * K2_OFF + KSWZ(r32, (dd * 16 + hi * 8) * 2);
    const int vb0 = (int)(uintptr_t)lds + V_OFF + att::v_rd_base(lane);
    float m_reg = -1e30f, l_reg = 0.f; f32x16 o[8] = {};
    f32x16 pA, pB; float alA, alB; bf16x8 pa0, pa1;
#define RESC(a) do { if (__any((a) < 1.f)) { if (hi == 0) al_l[r32] = (a); asm volatile("s_waitcnt lgkmcnt(0)" ::: "memory");              \
                     for (int d_ = 0; d_ < 8; ++d_) for (int r = 0; r < 16; ++r) o[d_][r] *= al_l[crow(r, hi)]; } } while (0)
#define NEAR(u) ((u) * 32 + 144 > qlo)
#define SM_PART(PX, alX, u) do { if (NEAR(u)) bias_mask16(PX, qm - (u) * 32, lut); partialSM16(PX, m_reg, alX, NEAR(u) ? 0.f : bfar); } while (0)
    A2_DMA(0); A2_DMA(1);
    A2_WAITV(8); A2_BAR();
    A2_DMA(2);
    SBAR(); qkt16(pA, lds, kofs, qr);
    SM_PART(pA, alA, 0);
#define STEP(PX, alX, PY, alY, u) do {                                                                       \
        if ((u) + 1 < NS) A2_WAITV(8); else A2_WAITV(0);                                                      \
        A2_BAR();                                                                                            \
        if ((u) + 2 < NS) A2_DMA((u) + 2);                                                                   \
        SBAR(); qkt16_exp(PX, PY, (int)(uintptr_t)lds + ((u) & 3) * STG, kofs, qr);                            \
        finish_pack16(PY, alY, l_reg, pa0, pa1); SBAR();                                                     \
        pv16(o, vb0 + (((u) - 1) & 3) * STG, pa0, pa1);                                                       \
        SM_PART(PX, alX, u);                                                                                 \
        RESC(alX); } while (0)
    for (int u = 1; u + 1 < NS; u += 2) {
        STEP(pB, alB, pA, alA, u);
        STEP(pA, alA, pB, alB, u + 1);
    }
    STEP(pB, alB, pA, alA, NS - 1);
    finishSM16(pB, alB, l_reg, pa0, pa1); SBAR();
    pv16(o, vb0 + ((NS - 1) & 3) * STG, pa0, pa1);
    if (hi == 0) li_l[r32] = l_reg;
    asm volatile("s_waitcnt lgkmcnt(0)" ::: "memory");
    float rli[16];
#pragma unroll
    for (int r = 0; r < 16; ++r) rli[r] = __builtin_amdgcn_rcpf(li_l[crow(r, hi)]);
    A2_BAR();
    float* xch = (float*)(lds + rg * 32768);
    if (mp == 1) {
#pragma unroll
        for (int r = 0; r < 16; ++r) { const float f = lam * rli[r];
#pragma unroll
            for (int d0 = 0; d0 < 8; ++d0) xch[crow(r, hi) * 256 + d0 * 32 + r32] = o[d0][r] * f; }
    }
    A2_BAR();
    if (mp == 0) {
        int lane_e = lane; asm volatile("" : "+v"(lane_e)); const int r32e = lane_e & 31;
        float ssq[16];
#pragma unroll
        for (int r = 0; r < 16; ++r) { float s = 0.f;
#pragma unroll
            for (int d0 = 0; d0 < 8; ++d0) { const float v = o[d0][r] * rli[r] - xch[crow(r, hi) * 256 + d0 * 32 + r32]; o[d0][r] = v; s += v * v; }
            ssq[r] = s; }
#pragma unroll
        for (int st = 1; st < 32; st <<= 1) {
#pragma unroll
            for (int r = 0; r < 16; ++r) ssq[r] += __int_as_float(__builtin_amdgcn_ds_bpermute((lane_e ^ st) << 2, __float_as_int(ssq[r]))); }
        float g[8];
#pragma unroll
        for (int d0 = 0; d0 < 8; ++d0) g[d0] = subln[d0 * 32 + r32e] * oml;
        char* Ow = (char*)(Ob + (size_t)qlo * OLD + h * 256); const unsigned ooff = (unsigned)(4 * hi * OLD + r32e) * 2u;
#pragma unroll
        for (int r = 0; r < 16; ++r) { const float rs = __builtin_amdgcn_rsqf(ssq[r] * (1.0f / 256.0f) + 1e-6f); const int orow0 = (r & 3) + 8 * (r >> 2);
#pragma unroll
            for (int d0 = 0; d0 < 8; ++d0) { const float v = o[d0][r] * rs * g[d0]; const float vn = __int_as_float(__builtin_amdgcn_ds_bpermute((lane_e ^ 1) << 2, __float_as_int(v)));
                if ((r32 & 1) == 0) *(unsigned*)(Ow + (size_t)(orow0 * OLD + d0 * 32) * 2 + ooff) = cvtpk(v, vn); } }
    }
    A2_WAITV(0); A2_BAR();
#undef A2_DMA
#undef RESC
#undef NEAR
#undef SM_PART
#undef STEP
}
#undef SBAR
}
template <bool EXIT>
__device__ __forceinline__ void attnB_phase(Frame& F, const bf16* Q, const bf16* KV, bf16* O) {
    int tid = CUR_TID(F);
    char* lds = (char*)(F.lds + RING_OFF);
    int vc0 = F.vcu; asm volatile("" : "+s"(vc0));
    for (int vc = vc0; vc < 256; vc += F.G) {
        const int bh = vc >> 3, p = vc & 7, b = bh >> 4, h = bh & 15;
        const bf16* Qb = Q + (size_t)b * SEQ * DM + h * 128; const bf16* Kb = KV + (size_t)b * SEQ * NKV + h * 128; const bf16* Vb = Kb + DM;
        bf16* Ob = O + (size_t)b * SEQ * DM + h * 128;
        for (int i = 0; i < 4; ++i) {
            const int qb = ((i >> 1) << 4) + ((i & 1) ? 15 - p : p);
            const att::BlockRef cur{Qb + (size_t)qb * 256 * DM, Kb, Vb, Ob + (size_t)qb * 256 * DM, qb * 256};
            att::sb_block<DM, NKV, NKV, DM, EXIT>(cur, lds, tid);
        }
    }
}

__device__ __forceinline__ void attnA2_phase(Frame& F, const bf16* QKV, bf16* O, const float* rel_bias, const float* lamv, const float* subln, int layer) {
    int tid = CUR_TID(F);
    const int lane = tid & 63;
    asm volatile("" : "+s"(layer)); const float lambda_init = layer == 0 ? 0.2f : 0.35550906759096924f;
    float s01 = 0.f, s23 = 0.f;
    for (int i = lane; i < 128; i += 64) { s01 += lamv[i] * lamv[128 + i]; s23 += lamv[256 + i] * lamv[384 + i]; }
    s01 = wave_sum(s01); s23 = wave_sum(s23);
    const float lam = expf(s01) - expf(s23) + lambda_init, oml = 1.0f - lambda_init;
    int vc0 = F.vcu; asm volatile("" : "+s"(vc0));
    for (int vc = vc0; vc < 256; vc += F.G) {
        const int bh = vc >> 4, p = vc & 15, b = bh >> 3, h = bh & 7;
        __syncthreads();
        asm volatile("" : "+v"(tid));
        { LAS float* lut = (LAS float*)(F.lds + att2::LDS_LUT);
          for (int i = tid; i < 2 * 272; i += 512) { const int mpi = i >= 272 ? 1 : 0; int n = i - mpi * 272 - 64; n = n < 0 ? 0 : n; lut[i] = rel_bias[t5_bucket(n) * 16 + 2 * h + mpi] * (1.0f / att::SCALE); } }
        const float bfar = rel_bias[31 * 16 + 2 * h + (tid >> 8)] * (1.0f / att::SCALE);
        __syncthreads();
        const bf16* QKVb = QKV + (size_t)b * SEQ * NQKV; bf16* Ob = O + (size_t)b * SEQ * DM;
        for (int i = 0; i < 4; ++i) {
            const int qb = ((i >> 1) << 5) + ((i & 1) ? 31 - p : p);
            att2::diff_unit<NQKV, DM>(QKVb, Ob, h, qb * 128, F.lds, tid, lam, oml, subln, bfar);
        }
    }
}

typedef const __attribute__((address_space(4))) Args* KArgs;
#define KARG() ({ KArgs ap_ = (KArgs)__builtin_amdgcn_kernarg_segment_ptr(); asm volatile("" : "+s"(ap_)); ap_; })
#define IN(k) (KARG()->in[k])
#define WS() (KARG()->ws)
__global__ void __launch_bounds__(NWAVES * 64, 2) mk_fwd(Args args_unused) {
    extern __shared__ __attribute__((aligned(16))) unsigned char lds[];
    Frame F;
    F.lds = (LAS unsigned char*)lds;
    F.MISC = (volatile LAS unsigned*)(F.lds + MISC_OFF);
    F.wave = __builtin_amdgcn_readfirstlane((int)threadIdx.x >> 6);
    F.G = gridDim.x; { const int bx = blockIdx.x; F.vcu = (F.G % 8 == 0) ? (bx % 8) * (F.G / 8) + bx / 8 : bx; }
    F.ctl = (gu32*)(WS() + WS_CTL);
    for (int u = threadIdx.x; u < (LDS_BYTES - LDSCTL_OFF) / 4; u += NWAVES * 64) ((LAS unsigned*)(F.lds + LDSCTL_OFF))[u] = 0u;
    __syncthreads();
    (void)xcd_barrier_post((unsigned*)(F.ctl + CW_BAR), F.MISC + 8);
#define GRID_BAR() do { XcdBarrier b_; b_.bar = (unsigned*)(WS() + WS_CTL) + CW_BAR; b_.x = xb_xcc_id(); b_.st = F.MISC + 8; b_.tid = CUR_TID(F); xcd_barrier(b_); } while (0)
#define XO() (KARG()->out)
#define WSP(off) ((bf16*)(WS() + (off)))
#define XN WSP(WS_XN)
#define OB WSP(WS_OB)
#define HB WSP(WS_H)
#define QKV WSP(WS_QKV)
#define KVSH WSP(WS_KVSH)

#define SSV(v) ((float*)(WS() + WS_SS) + (size_t)(v) * M * 32)
#define RSTAB ((PG8_LAS float*)(F.lds + RSTD_OFF))
    {
        LAS float* scr = (LAS float*)(F.lds + RING_OFF + F.wave * 16384);
        transpose_group<true >(F, F.vcu, F.G, IN(2), IN(1), 4, DM, NWI, (bf16*)(WS() + WS_WI_PRE), scr);
        transpose_group<true >(F, F.vcu, F.G, IN(6), IN(5), 4, DM, NWI, (bf16*)(WS() + WS_WI_POST), scr);
        transpose_group<false>(F, F.vcu, F.G, IN(9), IN(4), 2, DM, NQKV, (bf16*)(WS() + WS_AWQKV), scr);
        transpose_group<false>(F, F.vcu, F.G, IN(16), IN(15), 1, DM, NKV, (bf16*)(WS() + WS_BWKV), scr);
        cast_rows(F, IN(0), XN, SSV(0));
    }
    GRID_BAR();

    for (int l = 0; l < 4; ++l) {
        if (l == 2) {
            pg8::Gemm g{XN, (const bf16*)(WS() + WS_BWKV), M, NKV, DM}; pg8::StaticOrder S; S.init(M, NKV, F.G, (int)blockIdx.x);
            pg8::preload_rstd(S, SSV(6), RSTAB, CUR_TID(F));
            pg8::EpiBf16 E{KVSH, NKV, RSTAB};
            pg8::gemm_phase<pg8::EpiBf16, pg8::StaticOrder, true, true>(F.lds + RING_OFF, g, S, E, CUR_TID(F));
        }
        for (int s = 0; s < 2; ++s) {
            {
                const bf16* wi = (const bf16*)(WS() + (s ? WS_WI_POST : WS_WI_PRE) + (size_t)l * SZ_WI);
                pg8::Gemm g{XN, wi, M, NWI, DM}; pg8::StaticOrder S; S.init(M, NWI, F.G, (int)blockIdx.x);
                pg8::preload_rstd(S, SSV(3 * l + 2 * s), RSTAB, CUR_TID(F));
                pg8::EpiSwiGLU E{HB, DFF, RSTAB};
                pg8::gemm_phase<pg8::EpiSwiGLU, pg8::StaticOrder, true, true>(F.lds + RING_OFF, g, S, E, CUR_TID(F));
            }
            {
                const int rem_ = ((M / 256) * (NWI / 256)) % F.G, c_ = (int)blockIdx.x;
                if (rem_ == 0 || c_ >= rem_) {
                    const int part_ = rem_ ? c_ - rem_ : F.vcu, nparts_ = rem_ ? F.G - rem_ : F.G;
                    LAS float* scr = (LAS float*)(F.lds + RING_OFF + F.wave * 16384);
                    transpose_group<false>(F, part_, nparts_, (s ? IN(7) : IN(3)) + (size_t)l * DFF * DM, nullptr, 1, DFF, DM, (bf16*)(WS() + (s ? WS_WO_POST : WS_WO_PRE) + (size_t)l * SZ_WO), scr);
                    const float* xw = nullptr; const float* xg = nullptr; bf16* xd = nullptr; float xs = 1.0f;
                    if (s == 0) { if (l < 2) { xw = IN(14) + (size_t)l * DM * DM; xd = (bf16*)(WS() + WS_AWO + (size_t)l * SZ_DD); } else { xw = IN(18) + (size_t)(l - 2) * DM * DM; xd = (bf16*)(WS() + WS_BWO + (size_t)(l - 2) * SZ_DD); } }
                    else if (l == 1 || l == 2) { xw = IN(17) + (size_t)(l - 1) * DM * DM; xg = IN(4) + (size_t)(l + 1) * DM; xd = (bf16*)(WS() + WS_BWQ + (size_t)(l - 1) * SZ_DD); xs = att::SCALE * 1.4426950408889634f; }
                    if (xw) transpose_group<false>(F, part_, nparts_, xw, xg, 1, DM, DM, xd, scr, xs);
                }
            }
            GRID_BAR();
            {
                const bf16* wo = (const bf16*)(WS() + (s ? WS_WO_POST : WS_WO_PRE) + (size_t)l * SZ_WO);
                pg8::Gemm g{HB, wo, M, DM, DFF}; pg8::StaticOrder S; S.init(M, DM, F.G, (int)blockIdx.x);
                if (l == 3 && s == 1) {
                    pg8::EpiResid16<true> E{XN, nullptr, XO(), DM, 0.5f};
                    pg8::gemm_phase<pg8::EpiResid16<true>, pg8::StaticOrder, true, true>(F.lds + RING_OFF, g, S, E, CUR_TID(F));
                } else {
                    pg8::EpiResid16<false> E{XN, SSV(3 * l + 2 * s + 1), nullptr, DM, 0.5f};
                    pg8::gemm_phase<pg8::EpiResid16<false>, pg8::StaticOrder, false, true>(F.lds + RING_OFF, g, S, E, CUR_TID(F));
                }
            }
            GRID_BAR();
            if (s == 0) {
                if (l < 2) {
                    { LAS float* gl = (LAS float*)(F.lds + QKG_OFF); const int t_ = CUR_TID(F);
                      if (t_ < 256) gl[t_] = (t_ < 128 ? IN(10) + (size_t)l * HD : IN(11) + (size_t)l * HD - 128)[t_]; }
                    pg8::Gemm g{XN, (const bf16*)(WS() + WS_AWQKV + (size_t)l * SZ_AWQKV), M, NQKV, DM}; pg8::StaticOrder S; S.init(M, NQKV, F.G, (int)blockIdx.x);
                    pg8::preload_rstd(S, SSV(3 * l + 1), RSTAB, CUR_TID(F));
                    pg8::EpiQKV E{QKV, NQKV, (PG8_LAS float*)(F.lds + QKX_OFF), (const PG8_LAS float*)(F.lds + QKG_OFF), RSTAB};
                    pg8::gemm_phase<pg8::EpiQKV, pg8::StaticOrder, true, true>(F.lds + RING_OFF, g, S, E, CUR_TID(F));
                } else {
                    pg8::Gemm g{XN, (const bf16*)(WS() + WS_BWQ + (size_t)(l - 2) * SZ_DD), M, DM, DM}; pg8::StaticOrder S; S.init(M, DM, F.G, (int)blockIdx.x);
                    pg8::preload_rstd(S, SSV(3 * l + 1), RSTAB, CUR_TID(F));
                    pg8::EpiBf16 E{QKV, DM, RSTAB};
                    pg8::gemm_phase<pg8::EpiBf16, pg8::StaticOrder, true, true>(F.lds + RING_OFF, g, S, E, CUR_TID(F));
                }
                GRID_BAR();
                if (l < 2) {
                    attnA2_phase(F, QKV, OB, IN(8), IN(12) + (size_t)l * 512, IN(13) + (size_t)l * 256, l);
                } else {
                    attnB_phase<true>(F, QKV, KVSH, OB);
                }
                GRID_BAR();
                {
                    const bf16* w = (l < 2) ? (const bf16*)(WS() + WS_AWO + (size_t)l * SZ_DD) : (const bf16*)(WS() + WS_BWO + (size_t)(l - 2) * SZ_DD);
                    pg8::Gemm g{OB, w, M, DM, DM}; pg8::StaticOrder S; S.init(M, DM, F.G, (int)blockIdx.x);
                    pg8::EpiResid16<false> E{XN, SSV(3 * l + 2), nullptr, DM, 1.0f};
                    pg8::gemm_phase<pg8::EpiResid16<false>, pg8::StaticOrder, false, true>(F.lds + RING_OFF, g, S, E, CUR_TID(F));
                }
                GRID_BAR();
            }
        }
    }
#undef SSV
#undef RSTAB
#undef GRID_BAR
#undef XN
#undef OB
#undef HB
#undef QKV
#undef KVSH
}

extern "C" void kernel_launch(void* const* d_in, const int* in_sizes, int n_in, void* d_out, int out_size, void* d_ws, size_t ws_size, hipStream_t stream) {
    static int grid = 0;
    if (grid == 0) {
        if (n_in != 19 || in_sizes[0] != M * DM || out_size != M * DM || ws_size < WS_END) { fprintf(stderr, "kernel_launch: shape/workspace mismatch: n_in %d in0 %d out %d ws %zu (need %zu); nothing launched\n", n_in, n_in > 0 ? in_sizes[0] : -1, out_size, ws_size, (size_t)WS_END); grid = -1; return; }
        int dev = 0, cus = 0, per_cu = 0;
        if (hipGetDevice(&dev) != hipSuccess || hipDeviceGetAttribute(&cus, hipDeviceAttributeMultiprocessorCount, dev) != hipSuccess) { fprintf(stderr, "kernel_launch: device query failed\n"); grid = -1; return; }
        if (hipFuncSetAttribute((const void*)mk_fwd, hipFuncAttributeMaxDynamicSharedMemorySize, LDS_BYTES) != hipSuccess) { fprintf(stderr, "kernel_launch: hipFuncSetAttribute failed\n"); grid = -1; return; }
        if (hipOccupancyMaxActiveBlocksPerMultiprocessor(&per_cu, (const void*)mk_fwd, NWAVES * 64, LDS_BYTES) != hipSuccess || per_cu < 1)
            fprintf(stderr, "kernel_launch: note: occupancy query reports %d workgroups per CU\n", per_cu);
        (void)hipGetLastError();
        grid = cus;
    }
    if (grid < 0) return;
    if (hipMemsetAsync((char*)d_ws + WS_CTL, 0, CTL_ZERO_BYTES, stream) != hipSuccess) { fprintf(stderr, "kernel_launch: memset failed\n"); return; }
    Args a{};
    for (int i = 0; i < 19; ++i) a.in[i] = (const float*)d_in[i];
    a.out = (float*)d_out; a.ws = (unsigned char*)d_ws;
    hipLaunchKernelGGL(mk_fwd, dim3(grid), dim3(NWAVES * 64), LDS_BYTES, stream, a);
    const hipError_t le = hipPeekAtLastError();
    if (le != hipSuccess) fprintf(stderr, "kernel_launch: launch failed: %s\n", hipGetErrorName(le));
}
```

```cpp
#include <hip/hip_runtime.h>
__device__ __forceinline__ int lane_id() { unsigned z; asm volatile("s_mov_b32 %0, 0" : "=s"(z)); return (int)__builtin_amdgcn_mbcnt_hi(~0u, __builtin_amdgcn_mbcnt_lo(~0u, z)); }
__device__ __forceinline__ float shx(float v, int o) { return __int_as_float(__builtin_amdgcn_ds_bpermute((lane_id() ^ o) << 2, __float_as_int(v))); }
#include <hip/hip_runtime.h>
#include <cstdio>
#include <cstdint>
namespace pg8 {
#define PG8_LAS __attribute__((address_space(3)))
typedef unsigned short bf16_t;
typedef short bf16x8 __attribute__((ext_vector_type(8)));
typedef float f32x4 __attribute__((ext_vector_type(4)));
typedef unsigned u32x4 __attribute__((ext_vector_type(4)));
constexpr int BM = 256, BK = 64, HALF = 128, HTB = HALF * BK * 2  , STAGE_BYTES = 8 * HTB, NXCD = 8, WGM = 8;

__host__ __device__ __forceinline__ int lds_byte(int r, int c) { const int st = (r >> 4) * 2 + (c >> 5), rr = r & 15, cc = c & 31, ob = rr * 64 + cc * 2; return st * 1024 + (ob ^ (((ob >> 9) & 1) << 5)); }
__host__ __device__ __forceinline__ void stage_rc(int b, int& R, int& C) { const int st = b / 1024, sb = b % 1024, swz = sb ^ (((sb >> 9) & 1) << 5); R = (st >> 1) * 16 + swz / 64; C = (st & 1) * 32 + (swz % 64) / 2; }
__host__ __device__ __forceinline__ int perm32(int rho) { const int n = rho >> 4, i = rho & 15; return 8 * (i >> 2) + 4 * n + (i & 3); }

struct Unit { int pm, pn, idx; };
struct Gemm { const bf16_t* A; const bf16_t* Bt; int M, N, K; };

struct StaticOrder {
    int nM, nN, nwg, G, c;
    __host__ __device__ void init(int M, int N, int G_, int c_) { nM = M / BM; nN = N / BM; nwg = nM * nN; G = G_; c = c_; }
    __host__ __device__ bool next(int i, Unit& u) const {
        const long L = (long)i * G + c; if (L >= nwg) return false;
        int wgid = (int)L; { const int q = nwg / NXCD, r = nwg % NXCD, xcd = wgid % NXCD, off = wgid / NXCD; wgid = (xcd < r ? xcd * (q + 1) : r * (q + 1) + (xcd - r) * q) + off; }
        const int nig = WGM * nN, gid = wgid / nig, fm = gid * WGM, gsz = (nM - fm) < WGM ? (nM - fm) : WGM;
        u.pm = fm + ((wgid % nig) % gsz); u.pn = (wgid % nig) / gsz; u.idx = i; return true;
    }
    __device__ __forceinline__ void a_ready(const Unit&) const {}
    __device__ __forceinline__ void done(const Unit&) const {}
};

__device__ __forceinline__ unsigned cvt_pk_bf16(float lo, float hi) { unsigned r; asm volatile("v_cvt_pk_bf16_f32 %0, %1, %2" : "=v"(r) : "v"(lo), "v"(hi)); return r; }
template <class Sched>
__device__ __forceinline__ void preload_rstd(const Sched& S, const float* ss, PG8_LAS float* rs, int tid) {
    Unit u; const int sub = tid & 7, r0 = tid >> 3;
    int pm_have = -1; float val[4] = {0.f, 0.f, 0.f, 0.f};
    for (int i = 0; S.next(i, u); ++i) {
        if (u.pm != pm_have) {
            pm_have = u.pm;
#pragma unroll
            for (int j = 0; j < 4; ++j) {
                const f32x4 a = *(const f32x4*)(ss + (size_t)(u.pm * BM + r0 + 64 * j) * 32 + sub * 4); float s = (a[0] + a[1]) + (a[2] + a[3]);
                s += shx(s, 1); s += shx(s, 2); s += shx(s, 4);
                val[j] = __builtin_amdgcn_rsqf(s * (1.0f / 2048.0f) + 1e-6f); }
        }
        if (sub == 0) {
#pragma unroll
            for (int j = 0; j < 4; ++j) rs[i * 256 + r0 + 64 * j] = val[j]; }
    }
    asm volatile("s_waitcnt lgkmcnt(0)" ::: "memory"); __syncthreads();
}
__device__ __forceinline__ void row_rstd(float (&rs)[2][4], const PG8_LAS float* tab, const Unit& u, int wr, int fr) {
#pragma unroll
    for (int ai = 0; ai < 2; ++ai)
#pragma unroll
        for (int m = 0; m < 4; ++m) rs[ai][m] = tab[u.idx * 256 + ai * HALF + wr * 64 + m * 16 + fr];
}
struct EpiBf16 {
    static constexpr bool PERM = true, AFTER_DRAIN = false;
    bf16_t* O; int ldc; const PG8_LAS float* rstab;
    __device__ __forceinline__ void operator()(const f32x4 (&acc)[2][2][4][2], const Unit& u, int wr, int wc, int fr, int fq) const {
        const int row0 = u.pm * BM + wr * 64 + fr, col0 = u.pn * BM + wc * 32 + 8 * fq;
        float rs[2][4]; row_rstd(rs, rstab, u, wr, fr);
#pragma unroll
        for (int ai = 0; ai < 2; ++ai)
#pragma unroll
            for (int m = 0; m < 4; ++m) { bf16_t* rowp = O + (size_t)(row0 + ai * HALF + m * 16) * ldc + col0; const float r = rs[ai][m];
#pragma unroll
                for (int bj = 0; bj < 2; ++bj) { const f32x4 v0 = acc[ai][bj][m][0] * r, v1 = acc[ai][bj][m][1] * r;
                    u32x4 w; w.x = cvt_pk_bf16(v0[0], v0[1]); w.y = cvt_pk_bf16(v0[2], v0[3]); w.z = cvt_pk_bf16(v1[0], v1[1]); w.w = cvt_pk_bf16(v1[2], v1[3]);
                    *(u32x4*)(rowp + bj * HALF) = w; } }
    }
};
struct EpiQKV {
    static constexpr bool PERM = true, AFTER_DRAIN = false;
    bf16_t* O; int ldc; PG8_LAS float* xs; const PG8_LAS float* gains; const PG8_LAS float* rstab;
    __device__ __forceinline__ void operator()(const f32x4 (&acc)[2][2][4][2], const Unit& u, int wr, int wc, int fr, int fq) const {
        const int row0 = u.pm * BM + wr * 64 + fr, col0 = u.pn * BM + wc * 32 + 8 * fq;
        const bool nrm = u.pn < 16;
        float rs[2][4]; row_rstd(rs, rstab, u, wr, fr);
        if (nrm) {
#pragma unroll
            for (int ai = 0; ai < 2; ++ai)
#pragma unroll
                for (int m = 0; m < 4; ++m)
#pragma unroll
                    for (int bj = 0; bj < 2; ++bj) { const f32x4 a = acc[ai][bj][m][0] * rs[ai][m], b = acc[ai][bj][m][1] * rs[ai][m];
                        float s = ((a[0] * a[0] + a[1] * a[1]) + (a[2] * a[2] + a[3] * a[3])) + ((b[0] * b[0] + b[1] * b[1]) + (b[2] * b[2] + b[3] * b[3]));
                        s += shx(s, 16); s += shx(s, 32);
                        if (fq == 0) xs[(((wr * 128 + ai * 64 + m * 16 + fr) * 2 + bj) << 2) + wc] = s; }
        }
        asm volatile("s_waitcnt lgkmcnt(0)" ::: "memory"); __builtin_amdgcn_s_barrier(); asm volatile("" ::: "memory");
        f32x4 g0 = {1.f, 1.f, 1.f, 1.f}, g1 = g0;
        if (nrm) { const PG8_LAS float* gp = gains + (u.pn >= 8 ? 128 : 0) + wc * 32 + 8 * fq; g0 = *(const PG8_LAS f32x4*)gp; g1 = *(const PG8_LAS f32x4*)(gp + 4); }
#pragma unroll
        for (int ai = 0; ai < 2; ++ai)
#pragma unroll
            for (int m = 0; m < 4; ++m) { bf16_t* rowp = O + (size_t)(row0 + ai * HALF + m * 16) * ldc + col0;
#pragma unroll
                for (int bj = 0; bj < 2; ++bj) { f32x4 v0 = acc[ai][bj][m][0] * rs[ai][m], v1 = acc[ai][bj][m][1] * rs[ai][m];
                    if (nrm) { const f32x4 p = *(const PG8_LAS f32x4*)(xs + (((wr * 128 + ai * 64 + m * 16 + fr) * 2 + bj) << 2));
                        const float r = __builtin_amdgcn_rsqf(((p[0] + p[1]) + (p[2] + p[3])) * (1.0f / 128.0f) + 1e-6f); v0 = v0 * r * g0; v1 = v1 * r * g1; }
                    u32x4 w; w.x = cvt_pk_bf16(v0[0], v0[1]); w.y = cvt_pk_bf16(v0[2], v0[3]); w.z = cvt_pk_bf16(v1[0], v1[1]); w.w = cvt_pk_bf16(v1[2], v1[3]);
                    *(u32x4*)(rowp + bj * HALF) = w; } }
    }
};
__device__ __forceinline__ f32x4 silu_mul4(f32x4 g, f32x4 u, float nl, float r2) {
    f32x4 t = g * nl;
    t = (f32x4){__builtin_amdgcn_exp2f(t[0]), __builtin_amdgcn_exp2f(t[1]), __builtin_amdgcn_exp2f(t[2]), __builtin_amdgcn_exp2f(t[3])} + 1.0f;
    t = (f32x4){__builtin_amdgcn_rcpf(t[0]), __builtin_amdgcn_rcpf(t[1]), __builtin_amdgcn_rcpf(t[2]), __builtin_amdgcn_rcpf(t[3])} * r2;
    return (g * u) * t;
}
struct EpiSwiGLU {
    static constexpr bool PERM = true, AFTER_DRAIN = false;
    bf16_t* O; int ldc; const PG8_LAS float* rstab;
    __device__ __forceinline__ void operator()(const f32x4 (&acc)[2][2][4][2], const Unit& u, int wr, int wc, int fr, int fq) const {
        const int row0 = u.pm * BM + wr * 64 + fr, col0 = u.pn * HALF + wc * 32 + 8 * fq;
        float rs[2][4]; row_rstd(rs, rstab, u, wr, fr);
#pragma unroll
        for (int ai = 0; ai < 2; ++ai)
#pragma unroll
            for (int m = 0; m < 4; ++m) { bf16_t* rowp = O + (size_t)(row0 + ai * HALF + m * 16) * ldc + col0; const float r = rs[ai][m], nl = r * -1.4426950408889634f, r2 = r * r;
                const f32x4 g0 = acc[ai][0][m][0], g1 = acc[ai][0][m][1], u0 = acc[ai][1][m][0], u1 = acc[ai][1][m][1];
                const f32x4 h0 = silu_mul4(g0, u0, nl, r2), h1 = silu_mul4(g1, u1, nl, r2);
                u32x4 w; w.x = cvt_pk_bf16(h0[0], h0[1]); w.y = cvt_pk_bf16(h0[2], h0[3]); w.z = cvt_pk_bf16(h1[0], h1[1]); w.w = cvt_pk_bf16(h1[2], h1[3]);
                *(u32x4*)rowp = w; }
    }
};
template <bool FINAL>
struct EpiResid16 {
    static constexpr bool PERM = true, AFTER_DRAIN = false;
    bf16_t* x16; float* ss; float* outf; int ldc; float scale;
    __device__ __forceinline__ void operator()(const f32x4 (&acc)[2][2][4][2], const Unit& u, int wr, int wc, int fr, int fq) const {
        const int row0 = u.pm * BM + wr * 64 + fr, col0 = u.pn * BM + wc * 32 + 8 * fq;
        u32x4 b[2][4][2];
#pragma unroll
        for (int ai = 0; ai < 2; ++ai)
#pragma unroll
            for (int m = 0; m < 4; ++m)
#pragma unroll
                for (int bj = 0; bj < 2; ++bj) b[ai][m][bj] = *(const u32x4*)(x16 + (size_t)(row0 + ai * HALF + m * 16) * ldc + col0 + bj * HALF);
        asm volatile("" ::: "memory");
#pragma unroll
        for (int ai = 0; ai < 2; ++ai)
#pragma unroll
            for (int m = 0; m < 4; ++m) { const int row = row0 + ai * HALF + m * 16; const size_t off = (size_t)row * ldc + col0; float part = 0.f;
#pragma unroll
                for (int bj = 0; bj < 2; ++bj) { const u32x4 w0 = b[ai][m][bj];
                    f32x4 v0 = {__uint_as_float(w0.x << 16), __uint_as_float(w0.x & 0xffff0000u), __uint_as_float(w0.y << 16), __uint_as_float(w0.y & 0xffff0000u)};
                    f32x4 v1 = {__uint_as_float(w0.z << 16), __uint_as_float(w0.z & 0xffff0000u), __uint_as_float(w0.w << 16), __uint_as_float(w0.w & 0xffff0000u)};
                    v0 = v0 + acc[ai][bj][m][0] * scale; v1 = v1 + acc[ai][bj][m][1] * scale;
                    if (FINAL) { *(f32x4*)(outf + off + bj * HALF) = v0; *(f32x4*)(outf + off + bj * HALF + 4) = v1; }
                    else { u32x4 w; w.x = cvt_pk_bf16(v0[0], v0[1]); w.y = cvt_pk_bf16(v0[2], v0[3]); w.z = cvt_pk_bf16(v1[0], v1[1]); w.w = cvt_pk_bf16(v1[2], v1[3]);
                        *(u32x4*)(x16 + off + bj * HALF) = w;
                        const float r0 = __uint_as_float(w.x << 16), r1 = __uint_as_float(w.x & 0xffff0000u), r2 = __uint_as_float(w.y << 16), r3 = __uint_as_float(w.y & 0xffff0000u);
                        const float r4 = __uint_as_float(w.z << 16), r5 = __uint_as_float(w.z & 0xffff0000u), r6 = __uint_as_float(w.w << 16), r7 = __uint_as_float(w.w & 0xffff0000u);
                        part += ((r0 * r0 + r1 * r1) + (r2 * r2 + r3 * r3)) + ((r4 * r4 + r5 * r5) + (r6 * r6 + r7 * r7)); } }
                if (!FINAL) { part += shx(part, 16); part += shx(part, 32);
                    if (fq == 0) ss[(size_t)row * 32 + u.pn * 4 + wc] = part; } }
    }
};

template <class Epi, class Sched, bool ALIGN_EPI = false, bool SP2 = false>
__device__ __forceinline__ void gemm_phase(PG8_LAS unsigned char* lds, const Gemm g, const Sched& S, const Epi& E, int tid_in) {
    int tid_ = tid_in; asm volatile("" : "+v"(tid_));
    const int tid = tid_, wid = __builtin_amdgcn_readfirstlane(tid >> 6), lane = tid & 63, wr = wid >> 2, wc = wid & 3, fr = lane & 15, fq = lane >> 4;
    const int K = g.K, nt = K / BK;
    unsigned voffA[2], voffB[2];
#pragma unroll
    for (int i = 0; i < 2; ++i) { int R, C; stage_rc(tid * 16 + i * 8192, R, C); const int Rb = Epi::PERM ? ((R & ~31) + perm32(R & 31)) : R;
        voffA[i] = (unsigned)(R * K + C) * 2u; voffB[i] = (unsigned)(Rb * K + C) * 2u; }
    const size_t kstep = (size_t)(BK * 2);
    const size_t hstep = (size_t)HALF * K * 2;
    const size_t tstep = 2 * hstep;
    const unsigned ldsw = (unsigned)wid * 1024u;
    const int aoff = lds_byte(wr * 64 + fr, fq * 8), boff = lds_byte(wc * 32 + fr, fq * 8);
#define PG8_SA(b, h) (((b) * 2 + (h)) * HTB)
#define PG8_SB(b, h) ((4 + (b) * 2 + (h)) * HTB)
#define PG8_STAGE(bufoff, gbase, voff) do { _Pragma("unroll") for (int _i = 0; _i < 2; ++_i) \
        __builtin_amdgcn_global_load_lds((const unsigned*)((const char*)(gbase) + (voff)[_i]), (PG8_LAS unsigned*)(lds + (bufoff) + ldsw + _i * 8192), 16, 0, 0); } while (0)
#define PG8_LDA(dst, b, h) do { _Pragma("unroll") for (int m = 0; m < 4; ++m) _Pragma("unroll") for (int k = 0; k < 2; ++k) dst[m][k] = *(const PG8_LAS bf16x8*)(lds + PG8_SA(b, h) + aoff + m * 2048 + k * 1024); } while (0)
#define PG8_LDB(dst, b, h) do { _Pragma("unroll") for (int n = 0; n < 2; ++n) _Pragma("unroll") for (int k = 0; k < 2; ++k) dst[n][k] = *(const PG8_LAS bf16x8*)(lds + PG8_SB(b, h) + boff + n * 2048 + k * 1024); } while (0)
#define PG8_PRIO(x) __builtin_amdgcn_s_setprio(x)
#define PG8_MMA(ai, bj, At, Bt) do { PG8_PRIO(1); _Pragma("unroll") for (int m = 0; m < 4; ++m) _Pragma("unroll") for (int n = 0; n < 2; ++n) _Pragma("unroll") for (int k = 0; k < 2; ++k) \
        acc[ai][bj][m][n] = __builtin_amdgcn_mfma_f32_16x16x32_bf16(Bt[n][k], At[m][k], acc[ai][bj][m][n], 0, 0, 0); PG8_PRIO(0); } while (0)
#define PG8_WAIT_V(n) asm volatile("s_waitcnt vmcnt(" #n ")" ::: "memory")
#define PG8_WAIT_L(n) asm volatile("s_waitcnt lgkmcnt(" #n ")" ::: "memory")
#define PG8_BAR __builtin_amdgcn_s_barrier()
#define PG8_SCHED __builtin_amdgcn_sched_barrier(0)
    Unit cur, nxt; int ui = 0;
    if (!S.next(0, cur)) return;
    f32x4 acc[2][2][4][2];
#pragma unroll
    for (int a = 0; a < 2; ++a)
#pragma unroll
        for (int b = 0; b < 2; ++b)
#pragma unroll
            for (int m = 0; m < 4; ++m)
#pragma unroll
                for (int n = 0; n < 2; ++n) acc[a][b][m][n] = (f32x4){0.f, 0.f, 0.f, 0.f};
    bf16x8 At[4][2], B0[2][2], B1[2][2];
    const char* cA = (const char*)g.A + (size_t)cur.pm * tstep; const char* cB = (const char*)g.Bt + (size_t)cur.pn * tstep;
    S.a_ready(cur);
    if constexpr (SP2) {
        PG8_STAGE(PG8_SB(0, 0), cB, voffB); PG8_STAGE(PG8_SB(0, 1), cB + hstep, voffB); PG8_STAGE(PG8_SA(0, 0), cA, voffA); PG8_STAGE(PG8_SA(0, 1), cA + hstep, voffA);
        if (wr == 1) PG8_BAR;
        PG8_WAIT_V(2); PG8_BAR;
        PG8_STAGE(PG8_SB(1, 0), cB + kstep, voffB); PG8_STAGE(PG8_SA(1, 0), cA + kstep, voffA); PG8_STAGE(PG8_SB(1, 1), cB + hstep + kstep, voffB);
        PG8_WAIT_V(6); PG8_BAR;
    } else {
        PG8_STAGE(PG8_SB(0, 0), cB, voffB); PG8_STAGE(PG8_SA(0, 0), cA, voffA); PG8_STAGE(PG8_SB(0, 1), cB + hstep, voffB); PG8_STAGE(PG8_SA(0, 1), cA + hstep, voffA);
        if (wr == 1) PG8_BAR;
        PG8_WAIT_V(4); PG8_BAR;
        PG8_STAGE(PG8_SB(1, 0), cB + kstep, voffB); PG8_STAGE(PG8_SA(1, 0), cA + kstep, voffA); PG8_STAGE(PG8_SB(1, 1), cB + hstep + kstep, voffB);
        PG8_WAIT_V(6); PG8_BAR;
    }
    for (;;) {
        const bool has_next = S.next(ui + 1, nxt);
        const char* nA = has_next ? (const char*)g.A + (size_t)nxt.pm * tstep : cA; const char* nB = has_next ? (const char*)g.Bt + (size_t)nxt.pn * tstep : cB;
        for (int t = 0; t < nt; t += 2) {
            const bool last = (t == nt - 2);
            const char* a1 = cA + (size_t)(t + 1) * kstep;
            const char* a2 = last ? nA : cA + (size_t)(t + 2) * kstep; const char* b2 = last ? nB : cB + (size_t)(t + 2) * kstep;
            const char* a3 = a2 + kstep; const char* b3 = b2 + kstep;
            if (last && has_next) S.a_ready(nxt);
            if constexpr (SP2) {
            PG8_LDB(B0, 0, 0); PG8_LDB(B1, 0, 1); PG8_SCHED; PG8_LDA(At, 0, 0); PG8_STAGE(PG8_SA(1, 1), a1 + hstep, voffA);
            PG8_WAIT_V(8); PG8_WAIT_L(0); PG8_BAR; PG8_MMA(0, 0, At, B0); PG8_MMA(0, 1, At, B1); PG8_BAR; PG8_SCHED;
            PG8_LDA(At, 0, 1); PG8_STAGE(PG8_SB(0, 0), b2, voffB); PG8_STAGE(PG8_SB(0, 1), b2 + hstep, voffB); PG8_STAGE(PG8_SA(0, 0), a2, voffA);
            PG8_WAIT_V(8); PG8_WAIT_L(0); PG8_BAR; PG8_MMA(1, 0, At, B0); PG8_MMA(1, 1, At, B1); PG8_BAR; PG8_SCHED;
            PG8_LDB(B0, 1, 0); PG8_LDB(B1, 1, 1); PG8_SCHED; PG8_LDA(At, 1, 0); PG8_STAGE(PG8_SA(0, 1), a2 + hstep, voffA);
            PG8_WAIT_V(8); PG8_WAIT_L(0); PG8_BAR; PG8_MMA(0, 0, At, B0); PG8_MMA(0, 1, At, B1); PG8_BAR; PG8_SCHED;
            PG8_LDA(At, 1, 1); PG8_STAGE(PG8_SB(1, 0), b3, voffB); PG8_STAGE(PG8_SB(1, 1), b3 + hstep, voffB); PG8_STAGE(PG8_SA(1, 0), a3, voffA);
            PG8_WAIT_V(8); PG8_WAIT_L(0); PG8_BAR; PG8_MMA(1, 0, At, B0); PG8_MMA(1, 1, At, B1); PG8_BAR; PG8_SCHED;
            } else {
            PG8_LDB(B0, 0, 0); PG8_SCHED; PG8_LDA(At, 0, 0); PG8_STAGE(PG8_SA(1, 1), a1 + hstep, voffA);
            PG8_WAIT_L(8); PG8_BAR; PG8_WAIT_L(0); PG8_MMA(0, 0, At, B0); PG8_BAR; PG8_SCHED;
            PG8_LDB(B1, 0, 1); PG8_STAGE(PG8_SB(0, 0), b2, voffB);
            PG8_BAR; PG8_WAIT_L(0); PG8_MMA(0, 1, At, B1); PG8_BAR;
            PG8_LDA(At, 0, 1); PG8_STAGE(PG8_SA(0, 0), a2, voffA);
            PG8_BAR; PG8_WAIT_L(0); PG8_MMA(1, 0, At, B0); PG8_BAR; PG8_SCHED;
            PG8_STAGE(PG8_SB(0, 1), b2 + hstep, voffB);
            PG8_WAIT_V(6); PG8_BAR; PG8_MMA(1, 1, At, B1); PG8_BAR;
            PG8_LDB(B0, 1, 0); PG8_SCHED; PG8_LDA(At, 1, 0); PG8_STAGE(PG8_SA(0, 1), a2 + hstep, voffA);
            PG8_WAIT_L(8); PG8_BAR; PG8_WAIT_L(0); PG8_MMA(0, 0, At, B0); PG8_BAR; PG8_SCHED;
            PG8_LDB(B1, 1, 1); PG8_STAGE(PG8_SB(1, 0), b3, voffB);
            PG8_BAR; PG8_WAIT_L(0); PG8_MMA(0, 1, At, B1); PG8_BAR;
            PG8_LDA(At, 1, 1); PG8_STAGE(PG8_SA(1, 0), a3, voffA);
            PG8_BAR; PG8_WAIT_L(0); PG8_MMA(1, 0, At, B0); PG8_BAR; PG8_SCHED;
            PG8_STAGE(PG8_SB(1, 1), b3 + hstep, voffB);
            PG8_WAIT_V(6); PG8_BAR; PG8_MMA(1, 1, At, B1); PG8_BAR;
            }
        }
        if constexpr (ALIGN_EPI) { if (wr == 0) PG8_BAR; }
        if constexpr (!Epi::AFTER_DRAIN) { E(acc, cur, wr, wc, fr, fq); S.done(cur); }
        if (!has_next) break;
#pragma unroll
        for (int a = 0; a < 2; ++a)
#pragma unroll
            for (int b = 0; b < 2; ++b)
#pragma unroll
                for (int m = 0; m < 4; ++m)
#pragma unroll
                    for (int n = 0; n < 2; ++n) { double z0_, z1_; asm volatile("v_mov_b64 %0, 0\n\tv_mov_b64 %1, 0" : "=v"(z0_), "=v"(z1_)); typedef double f64x2_ __attribute__((ext_vector_type(2))); acc[a][b][m][n] = __builtin_bit_cast(f32x4, (f64x2_){z0_, z1_}); }
        cur = nxt; cA = nA; cB = nB; ++ui;
        if constexpr (ALIGN_EPI) { if (wr == 1) PG8_BAR; }
    }
    PG8_WAIT_V(0);
    if constexpr (!ALIGN_EPI) { if (wr == 0) PG8_BAR; }
    PG8_BAR;
    if constexpr (Epi::AFTER_DRAIN) { E.fused(acc, cur, wr, wc, fr, fq, lds, wid, lane); S.done(cur); }
#undef PG8_SA
#undef PG8_SB
#undef PG8_STAGE
#undef PG8_LDA
#undef PG8_LDB
#undef PG8_MMA
#undef PG8_WAIT_V
#undef PG8_WAIT_L
#undef PG8_BAR
#undef PG8_SCHED
}
}

constexpr int NWAVES = 8;
constexpr int BATCH = 2, SEQ = 8192, DM = 2048, DFF = 5504, HD = 128;
constexpr int M = BATCH * SEQ;
constexpr int NQKV = 3 * DM, NKV = 2 * DM, NWI = 2 * DFF;
constexpr float EPS = 1e-6f;
constexpr float ATT_SCALE = 0.08838834764831845f;

constexpr size_t MiB = 1u << 20;
constexpr size_t WS_CTL = 0, CTL_ZERO_BYTES = 32 * 1024  ;
constexpr size_t SZ_WI = (size_t)NWI * DM * 2, SZ_WO = (size_t)DM * DFF * 2;
constexpr size_t WS_WI_PRE = 2 * MiB, WS_WI_POST = WS_WI_PRE + 4 * SZ_WI, WS_WO_PRE = WS_WI_POST + 4 * SZ_WI, WS_WO_POST = WS_WO_PRE + 4 * SZ_WO;
constexpr size_t WS_AWQKV = WS_WO_POST + 4 * SZ_WO, SZ_AWQKV = (size_t)NQKV * DM * 2;
constexpr size_t WS_AWO = WS_AWQKV + 2 * SZ_AWQKV, SZ_DD = (size_t)DM * DM * 2;
constexpr size_t WS_BWKV = WS_AWO + 2 * SZ_DD, WS_BWQ = WS_BWKV + 2 * SZ_DD, WS_BWO = WS_BWQ + 2 * SZ_DD;
constexpr size_t WS_LUT = WS_BWO + 2 * SZ_DD;
constexpr size_t WS_XN = WS_LUT + 1 * MiB, SZ_MD = (size_t)M * DM * 2;
constexpr size_t WS_OB = WS_XN + SZ_MD;
constexpr size_t WS_H = WS_OB + SZ_MD, SZ_H = (size_t)M * DFF * 2;
constexpr size_t WS_QKV = WS_H + SZ_H, SZ_QKV = (size_t)M * NQKV * 2;
constexpr size_t WS_KVSH = WS_QKV + SZ_QKV, SZ_KVSH = (size_t)M * NKV * 2;
constexpr size_t WS_SS = WS_KVSH + SZ_KVSH, SZ_SS = (size_t)M * 32 * 4;
constexpr size_t WS_END = WS_SS + 13 * SZ_SS;
constexpr int CW_TMO = 0, CW_CODE = 1;
constexpr int CW_BAR = 4096;
constexpr int RING_OFF = 0, RING_BYTES = 131072;
constexpr int LDSCTL_OFF = RING_BYTES, MISC_OFF = LDSCTL_OFF + 320;
constexpr int QKG_OFF = LDSCTL_OFF + 512, QKX_OFF = QKG_OFF + 1024;
constexpr int RSTD_OFF = QKX_OFF + 8192;
constexpr int LDS_BYTES = 155648;
static_assert(MISC_OFF + 128 <= QKG_OFF && RSTD_OFF + 11 * 1024 <= LDS_BYTES && LDS_BYTES <= 163840, "LDS map");

#define GAS __attribute__((address_space(1)))
#define LAS __attribute__((address_space(3)))
typedef unsigned short bf16;
typedef unsigned v4u __attribute__((ext_vector_type(4)));
typedef float f32x4 __attribute__((ext_vector_type(4)));
typedef short bf16x8 __attribute__((ext_vector_type(8)));
typedef GAS unsigned gu32;
typedef GAS unsigned long long gu64;
#define RLX_AGENT __ATOMIC_RELAXED, __HIP_MEMORY_SCOPE_AGENT
#define LDS_WAIT() asm volatile("s_waitcnt lgkmcnt(0)" ::: "memory")
#define VM_WAIT() asm volatile("s_waitcnt vmcnt(0)" ::: "memory")
__device__ __forceinline__ unsigned long long rt() { return __builtin_amdgcn_s_memrealtime(); }
__device__ __forceinline__ unsigned f2bf(float f) { unsigned u = __builtin_bit_cast(unsigned, f); return (u + 0x7fffu + ((u >> 16) & 1u)) >> 16; }
__device__ __forceinline__ unsigned pk2(float lo, float hi) { return f2bf(lo) | (f2bf(hi) << 16); }

#define XB_TMO      128
#define XB_XCNT(j)  (256  + 64 * (j))
#define XB_XSUB(j)  (1280 + 64 * (j))
#define XB_XGEN(j)  (2304 + 64 * (j))
#define XB_TOP      3328
#define XB_TOPGEN   3392
#define XCD_BAR_WORDS 3456
#define XB_SPIN_CAP (1u << 18)

__device__ __forceinline__ unsigned xb_ld(unsigned* p)              { return __hip_atomic_load(p, __ATOMIC_RELAXED, __HIP_MEMORY_SCOPE_AGENT); }
__device__ __forceinline__ unsigned xb_add(unsigned* p, unsigned v) { return __hip_atomic_fetch_add(p, v, __ATOMIC_RELAXED, __HIP_MEMORY_SCOPE_AGENT); }
__device__ __forceinline__ unsigned xb_xcc_id() { return (unsigned)__builtin_amdgcn_s_getreg((3 << 11) | 20) & 0xFu; }
#define XB_SPIN(cond, bar) do { unsigned _sp = 0; while (cond) { __builtin_amdgcn_s_sleep(1); \
    if ((++_sp & 255u) == 0u) { if (xb_ld(&(bar)[XB_TMO])) break; if (_sp > XB_SPIN_CAP) { atomicAdd(&(bar)[XB_TMO], 1u); break; } } } } while (0)

struct XcdBarrier {
    unsigned* bar; unsigned x; int tid;
    volatile LAS unsigned* st;
};

__device__ __forceinline__ XcdBarrier xcd_barrier_post(unsigned* bar, volatile LAS unsigned* st) {
    XcdBarrier b; b.bar = bar; b.x = xb_xcc_id(); b.st = st; b.tid = (int)threadIdx.x;
    if (threadIdx.x == 0) (void)xb_add(&bar[XB_XCNT(b.x)], 1u);
    return b;
}
__device__ __forceinline__ void xcd_barrier_complete(unsigned* bar, unsigned x, unsigned& nloc, unsigned& nx) {
    const unsigned G = gridDim.x * gridDim.y * gridDim.z;
    unsigned sum, cnt, mine, sp = 0u;
    for (;;) {
        sum = 0u; cnt = 0u; mine = 0u;
#pragma unroll
        for (unsigned j = 0; j < 16; ++j) { const unsigned c = xb_ld(&bar[XB_XCNT(j)]); sum += c; cnt += (c > 0u) ? 1u : 0u; mine = (j == x) ? c : mine; }
        if (sum == G) break;
        __builtin_amdgcn_s_sleep(1);
        if ((++sp & 255u) == 0u) { if (xb_ld(&bar[XB_TMO])) break; if (sp > XB_SPIN_CAP) { atomicAdd(&bar[XB_TMO], 1u); break; } }
    }
    nloc = mine > 0u ? mine : 1u; nx = cnt > 0u ? cnt : 1u;
}

__device__ __forceinline__ void xcd_barrier(const XcdBarrier& b) {
    asm volatile("s_waitcnt vmcnt(0)" ::: "memory");
    __syncthreads();
    int tid0_ = b.tid; asm volatile("" : "+v"(tid0_));
    if (tid0_ == 0) {
        unsigned* bar = b.bar;
        __builtin_amdgcn_s_waitcnt(0);
        unsigned nloc = b.st[0], nx = b.st[1];
        if (nloc == 0u) { xcd_barrier_complete(bar, b.x, nloc, nx); b.st[0] = nloc; b.st[1] = nx; }
        const unsigned old = xb_add(&bar[XB_XSUB(b.x)], 1u);
        const unsigned gen = old / nloc;
        if (old + 1u == (gen + 1u) * nloc) {
            __builtin_amdgcn_fence(__ATOMIC_RELEASE, "agent");
            asm volatile("s_waitcnt vmcnt(0)" ::: "memory");
            const unsigned og = xb_add(&bar[XB_TOP], 1u);
            const unsigned tg = og / nx;
            if (og + 1u == (tg + 1u) * nx) xb_add(&bar[XB_TOPGEN], 1u);
            else XB_SPIN(xb_ld(&bar[XB_TOPGEN]) == tg, bar);
            __builtin_amdgcn_fence(__ATOMIC_ACQUIRE, "agent");
            xb_add(&bar[XB_XGEN(b.x)], 1u);
            asm volatile("s_waitcnt vmcnt(0)" ::: "memory");
        } else {
            XB_SPIN(xb_ld(&bar[XB_XGEN(b.x)]) == gen, bar);
            __builtin_amdgcn_fence(__ATOMIC_ACQUIRE, "agent");
            asm volatile("s_waitcnt vmcnt(0)" ::: "memory");
        }
    }
    __syncthreads();
}

struct Args { const float* in[19]; float* out; unsigned char* ws; };
__device__ __forceinline__ int launder_v(int v) { asm volatile("" : "+v"(v)); return v; }
#define CUR_TID(F) (((F).wave << 6) | lane_id())
struct Frame {
    LAS unsigned char* lds;
    volatile LAS unsigned* MISC;
    gu32* ctl;
    int wave;
    int vcu, G;
};
__device__ __forceinline__ float wave_sum(float v) {
#pragma unroll
    for (int o = 1; o < 64; o <<= 1) v += shx(v, o);
    return v;
}
__device__ __forceinline__ float wave_max(float v) {
#pragma unroll
    for (int o = 1; o < 64; o <<= 1) v = fmaxf(v, shx(v, o));
    return v;
}
__device__ __forceinline__ float bf2f(unsigned short h) { return __uint_as_float((unsigned)h << 16); }
__device__ __forceinline__ float bflo(unsigned w) { return __uint_as_float(w << 16); }
__device__ __forceinline__ float bfhi(unsigned w) { return __uint_as_float(w & 0xffff0000u); }

__device__ __forceinline__ int t5_bucket(int n) {
    if (n < 16) return n;
    if (n >= 113) return 31;
    int b = 16;
    b += (n >= 19); b += (n >= 21); b += (n >= 24); b += (n >= 27); b += (n >= 31); b += (n >= 35); b += (n >= 40); b += (n >= 46);
    b += (n >= 52); b += (n >= 59); b += (n >= 67); b += (n >= 77); b += (n >= 87); b += (n >= 99);
    return b;
}

template <bool GLU>
__device__ __forceinline__ void transpose_group(Frame& F, int part, int nparts, const float* W, const float* gain, int L, int K, int N, bf16* WT, LAS float* scr, float wscale = 1.0f) {
    int gw = part * NWAVES + F.wave; asm volatile("" : "+s"(gw)); const int NGW = nparts * NWAVES; const int lane = lane_id();
    const int nblk = N / 32, kblk = K / 64, per = nblk * kblk, total = L * per;
    const int c = lane & 7, lr = lane >> 3;
    f32x4 v[8], g0 = {1.f, 1.f, 1.f, 1.f}, g1 = g0;
#define TG_DECODE(it_) const int l_ = (it_) / per, r_ = (it_) - l_ * per, kb_ = r_ / nblk, nb_ = r_ - kb_ * nblk, n0_ = nb_ * 32, k0_ = kb_ * 64; const size_t lo_ = (size_t)l_ * K * N;
#define TG_LOAD(it_) do { TG_DECODE(it_); const float* w_ = W + lo_ + (size_t)(k0_ + lr) * N + n0_ + 4 * c;                                                   \
        _Pragma("unroll") for (int i = 0; i < 8; ++i) v[i] = *(const GAS f32x4*)(w_ + (size_t)(8 * i) * N);                                                    \
        if (gain) { const float* g_ = gain + (size_t)l_ * K + k0_ + 8 * c; g0 = *(const GAS f32x4*)g_; g1 = *(const GAS f32x4*)(g_ + 4); } } while (0)
    if (gw < total) TG_LOAD(gw);
    for (int it = gw; it < total; it += NGW) {
#pragma unroll
        for (int i = 0; i < 8; ++i) { LAS float* d = scr + (8 * i + lr) * 33 + 4 * c; d[0] = v[i].x; d[1] = v[i].y; d[2] = v[i].z; d[3] = v[i].w; }
        const f32x4 h0 = g0 * wscale, h1 = g1 * wscale;
        LDS_WAIT(); asm volatile("" ::: "memory");
        if (it + NGW < total) TG_LOAD(it + NGW);
        TG_DECODE(it);
        int drow0 = n0_;
        if (GLU) { const int half = N / 2; const int cc = n0_ >= half ? n0_ - half : n0_; drow0 = (cc >> 7) * 256 + (n0_ >= half ? 128 : 0) + (cc & 127); }
        bf16* wt_ = WT + lo_ + (size_t)drow0 * K + k0_ + 8 * c;
#pragma unroll
        for (int j = 0; j < 4; ++j) { const int n = lr + 8 * j; const LAS float* s = scr + (8 * c) * 33 + n;
            v4u o; o.x = pg8::cvt_pk_bf16(s[0 * 33] * h0.x, s[1 * 33] * h0.y); o.y = pg8::cvt_pk_bf16(s[2 * 33] * h0.z, s[3 * 33] * h0.w); o.z = pg8::cvt_pk_bf16(s[4 * 33] * h1.x, s[5 * 33] * h1.y); o.w = pg8::cvt_pk_bf16(s[6 * 33] * h1.z, s[7 * 33] * h1.w);
            *(GAS v4u*)(wt_ + (size_t)n * K) = o; }
        LDS_WAIT(); asm volatile("" ::: "memory");
    }
#undef TG_LOAD
#undef TG_DECODE
}
__device__ __forceinline__ void cast_rows(Frame& F, const float* x, bf16* xb, float* ss) {
    int gw = F.vcu * NWAVES + F.wave; asm volatile("" : "+s"(gw)); const int NGW = F.G * NWAVES; const int lane = lane_id();
    for (int m = gw; m < M; m += NGW) {
        const GAS f32x4* xr = (const GAS f32x4*)(x + (size_t)m * DM) + lane;
        f32x4 v[8]; float s = 0.f;
#pragma unroll
        for (int j = 0; j < 8; ++j) { v[j] = xr[64 * j]; s += (v[j].x * v[j].x + v[j].y * v[j].y) + (v[j].z * v[j].z + v[j].w * v[j].w); }
        s = wave_sum(s);
        GAS unsigned long long* o8 = (GAS unsigned long long*)(xb + (size_t)m * DM) + lane;
#pragma unroll
        for (int j = 0; j < 8; ++j) o8[64 * j] = (unsigned long long)pk2(v[j].x, v[j].y) | ((unsigned long long)pk2(v[j].z, v[j].w) << 32);
        if (lane < 32) ss[(size_t)m * 32 + lane] = lane == 0 ? s : 0.f;
    }
}
namespace att {
typedef short s16x4 __attribute__((ext_vector_type(4)));
typedef float f32x16 __attribute__((ext_vector_type(16)));
typedef unsigned u32x4 __attribute__((ext_vector_type(4)));
constexpr int NW = 8, QBLK = 32, KVBLK = 64, QB = NW * QBLK, D = 128;
constexpr int SHM_V = KVBLK * D * 2, SHM_K = KVBLK * D * 2;
constexpr int LDS_WS = 2 * SHM_V + 2 * SHM_K;
constexpr float SCALE = 0.08838834764831845f;
#define KSWZ(row, colB) ((row) * 256 + ((colB) ^ (((row) & 7) << 4)))
#define SBAR() __builtin_amdgcn_sched_barrier(0)
__device__ __forceinline__ int v_st(int k, int c) { const int kk = (k & ~0xC) | ((k & 4) << 1) | ((k & 8) >> 1); return ((kk >> 3) * 4 + (c >> 5)) * 512 + ((kk & 7) * 32 + (c & 31)) * 2; }
__device__ __forceinline__ int v_rd_base(int lane) { return ((lane & 3) << 3) | (((lane >> 2) & 3) << 6) | (((lane >> 4) & 1) << 5) | (((lane >> 5) & 1) << 8); }
constexpr int v_rd_off(int d0, int ks, int half) { return d0 * 512 + ks * 4096 + half * 2048; }
__device__ __forceinline__ int crow(int r, int hi) { return (r & 3) + 8 * (r >> 2) + 4 * hi; }
__device__ __forceinline__ unsigned cvtpk(float lo, float hi) { unsigned r; asm volatile("v_cvt_pk_bf16_f32 %0, %1, %2" : "=v"(r) : "v"(lo), "v"(hi)); return r; }
__device__ __forceinline__ bf16x8 load8(const bf16* p) { return *reinterpret_cast<const bf16x8*>(p); }

#define PK4(P, B_, OUT) do { unsigned a0 = cvtpk(P[B_+0], P[B_+1]), a1 = cvtpk(P[B_+2], P[B_+3]);                          \
        unsigned b0 = cvtpk(P[B_+4], P[B_+5]), b1 = cvtpk(P[B_+6], P[B_+7]);                                             \
        auto r0 = __builtin_amdgcn_permlane32_swap(a0, b0, false, false); auto r1 = __builtin_amdgcn_permlane32_swap(a1, b1, false, false); \
        u32x4 w = {r0[0], r1[0], r0[1], r1[1]}; OUT = *reinterpret_cast<bf16x8*>(&w); } while (0)
template <int KB>
__device__ __forceinline__ void qkt(f32x16& p0, f32x16& p1, const char* K_lds, int r32, int hi, const bf16x8* qr) {
    p0 = f32x16{}; p1 = f32x16{};
    const char* kb[4];
#pragma unroll
    for (int dd = 0; dd < 4; ++dd) kb[dd] = K_lds + KB * SHM_K + KSWZ(r32, (dd * 16 + hi * 8) * 2);
#pragma unroll
    for (int d0 = 0; d0 < 8; ++d0) { const char* a = kb[d0 & 3] + (d0 >> 2) * 128;
        bf16x8 b0 = *reinterpret_cast<const bf16x8*>(a);
        bf16x8 b1 = *reinterpret_cast<const bf16x8*>(a + 32 * 256);
        p0 = __builtin_amdgcn_mfma_f32_32x32x16_bf16(b0, qr[d0], p0, 0, 0, 0);
        p1 = __builtin_amdgcn_mfma_f32_32x32x16_bf16(b1, qr[d0], p1, 0, 0, 0); }
}
template <int VB>
__device__ __forceinline__ void pv_tile(f32x16* o, int vb0, bf16x8 pa0, bf16x8 pa1, bf16x8 pa2, bf16x8 pa3) {
#define TRRD(dst, off) asm volatile("ds_read_b64_tr_b16 %0, %1 offset:%2" : "=&v"(dst) : "v"(vb0), "i"(off) : "memory")
#define PV_D0(d0) do { s16x4 l0, l1, l2, l3, h0, h1, h2, h3; constexpr int b_ = VB * SHM_V + v_rd_off(d0, 0, 0);   \
        TRRD(l0, b_); TRRD(h0, b_ + 2048); TRRD(l1, b_ + 4096); TRRD(h1, b_ + 6144); TRRD(l2, b_ + 8192); TRRD(h2, b_ + 10240); TRRD(l3, b_ + 12288); TRRD(h3, b_ + 14336); \
        asm volatile("s_waitcnt lgkmcnt(0)" ::: "memory"); SBAR();   \
        o[d0] = __builtin_amdgcn_mfma_f32_32x32x16_bf16(pa0, (bf16x8){l0[0], l0[1], l0[2], l0[3], h0[0], h0[1], h0[2], h0[3]}, o[d0], 0, 0, 0);   \
        o[d0] = __builtin_amdgcn_mfma_f32_32x32x16_bf16(pa1, (bf16x8){l1[0], l1[1], l1[2], l1[3], h1[0], h1[1], h1[2], h1[3]}, o[d0], 0, 0, 0);   \
        o[d0] = __builtin_amdgcn_mfma_f32_32x32x16_bf16(pa2, (bf16x8){l2[0], l2[1], l2[2], l2[3], h2[0], h2[1], h2[2], h2[3]}, o[d0], 0, 0, 0);   \
        o[d0] = __builtin_amdgcn_mfma_f32_32x32x16_bf16(pa3, (bf16x8){l3[0], l3[1], l3[2], l3[3], h3[0], h3[1], h3[2], h3[3]}, o[d0], 0, 0, 0); } while (0)
    PV_D0(0); PV_D0(1); PV_D0(2); PV_D0(3);
#undef PV_D0
#undef TRRD
}

struct BlockRef { const bf16* Q; const bf16* K; const bf16* V; bf16* O; int P0; };
struct Seam { bf16x8 qr[8]; bf16x8 st_v0, st_v1, st_k0, st_k1; };
#define LD16(base, boff) (*(const bf16x8*)((const char*)(base) + (size_t)(boff) + loff))
#define VMW() asm volatile("s_waitcnt vmcnt(0)" ::: "memory")
#define SLOAD_H(Kp, Vp, k0) do { const size_t ko_ = (size_t)(k0) * KS * 2; S.st_v0 = LD16(Vp, ko_); S.st_v1 = LD16(Vp, ko_ + 32 * VS * 2);              \
                         S.st_k0 = LD16(Kp, ko_); S.st_k1 = LD16(Kp, ko_ + 32 * KS * 2); } while (0)
#define SWRITE_HK(bf) do { *(bf16x8*)(K_lds + (bf) * SHM_K + kws) = S.st_k0; *(bf16x8*)(K_lds + (bf) * SHM_K + kws + 32 * 256) = S.st_k1; } while (0)
#define SWRITE_HV(bf) do { *(bf16x8*)(V_lds + (bf) * SHM_V + vst0) = S.st_v0; *(bf16x8*)(V_lds + (bf) * SHM_V + vst1) = S.st_v1; } while (0)
#define SWRITE_H(bf) do { SWRITE_HV(bf); SWRITE_HK(bf); } while (0)

__device__ __forceinline__ void sb_weights(f32x16& p0, f32x16& p1, int dq, bool need_mask, int hi, float& C, bf16x8& pa0, bf16x8& pa1, bf16x8& pa2, bf16x8& pa3) {
    float qs[8], osi[9];
#pragma unroll
    for (int g = 0; g < 8; ++g) {
        float lk[4], y[4];
#pragma unroll
        for (int i = 0; i < 4; ++i) {
            y[i] = g < 4 ? p0[4 * g + i] : p1[4 * (g - 4) + i];
            const float sp = fmaxf(y[i], 0.f) + __builtin_amdgcn_logf(1.0f + __builtin_amdgcn_exp2f(-fabsf(y[i])));
            const int c = i + 8 * g;
            const bool valid = !need_mask || (dq - c > 0);
            lk[i] = valid ? -sp : 0.f;
            y[i] = valid ? y[i] : -__builtin_inff();
        }
        const float s2 = lk[3], s1 = s2 + lk[2], s0 = s1 + lk[1];
        qs[g] = s0 + lk[0];
        const float e0 = y[0] + lk[0] + s0, e1 = y[1] + lk[1] + s1, e2 = y[2] + lk[2] + s2, e3 = y[3] + lk[3];
        if (g < 4) { p0[4 * g] = e0; p0[4 * g + 1] = e1; p0[4 * g + 2] = e2; p0[4 * g + 3] = e3; }
        else { p1[4 * (g - 4)] = e0; p1[4 * (g - 4) + 1] = e1; p1[4 * (g - 4) + 2] = e2; p1[4 * (g - 4) + 3] = e3; }
    }
    osi[8] = 0.f;
#pragma unroll
    for (int g = 7; g >= 0; --g) osi[g] = qs[g] + osi[g + 1];
    float tot;
    { auto rr = __builtin_amdgcn_permlane32_swap(__float_as_uint(osi[0]), __float_as_uint(osi[0]), false, false); tot = __uint_as_float(rr[0]) + __uint_as_float(rr[1]); }
#pragma unroll
    for (int g = 0; g < 8; ++g) {
        auto rr = __builtin_amdgcn_permlane32_swap(__float_as_uint(osi[g]), __float_as_uint(osi[g + 1]), false, false);
        const float T = osi[g + 1] + (hi ? __uint_as_float(rr[0]) : __uint_as_float(rr[1])) + C;
#pragma unroll
        for (int i = 0; i < 4; ++i) {
            if (g < 4) p0[4 * g + i] = __builtin_amdgcn_exp2f(p0[4 * g + i] + T); else p1[4 * (g - 4) + i] = __builtin_amdgcn_exp2f(p1[4 * (g - 4) + i] + T);
        }
    }
    C += tot;
    PK4(p0, 0, pa0); PK4(p0, 8, pa1); PK4(p1, 0, pa2); PK4(p1, 8, pa3);
}
template <int QS, int KS, int VS, int OS, bool EXIT>
__device__ __forceinline__ void sb_block(const BlockRef& cur, char* lds, int tid) {
    static_assert(KS == VS, "one lane offset serves K and V");
    const int wid = __builtin_amdgcn_readfirstlane(tid >> 6), lane = tid & 63, r32 = lane & 31, hi = lane >> 5;
    const int NT = cur.P0 / KVBLK + 4;
    const int qlo = cur.P0 + wid * QBLK, qm = qlo + r32 - 4 * hi;
    char* V_lds = lds; char* K_lds = lds + 2 * SHM_V;
    volatile LAS unsigned* flags = (volatile LAS unsigned*)(uintptr_t)((unsigned)(uintptr_t)lds + LDS_WS);
    const int sr = tid >> 4, sc = (tid & 15) * 8, vst0 = v_st(sr, sc), vst1 = v_st(32 + sr, sc), kws = KSWZ(sr, sc * 2);
    const unsigned loff = (unsigned)(sr * KS + sc) * 2u, qoff = (unsigned)(r32 * QS + hi * 8) * 2u;
    const int vb0 = (int)(uintptr_t)V_lds + v_rd_base(lane);
    Seam S;
#pragma unroll
    for (int d0 = 0; d0 < 8; ++d0) S.qr[d0] = *(const bf16x8*)((const char*)cur.Q + (size_t)(wid * QBLK) * QS * 2 + d0 * 32 + qoff);
#define KBASE(t) ((NT - 1 - (t)) * KVBLK)
    SLOAD_H(cur.K, cur.V, KBASE(0)); VMW(); SWRITE_H(0);
    SLOAD_H(cur.K, cur.V, KBASE(1));
    __syncthreads();
    f32x16 o[4] = {}; float C = 0.f; f32x16 p0, p1; bf16x8 pa0, pa1, pa2, pa3;
    bool wdone = false;
#define SB_STEP(t, B) do {                                                                                       \
        { const int kb_ = KBASE(t);                                                                               \
          if (!wdone && kb_ < qlo + QBLK) {                  \
            SBAR(); qkt<B>(p0, p1, K_lds, r32, hi, S.qr);                                                          \
            sb_weights(p0, p1, qm - kb_, kb_ + KVBLK > qlo, hi, C, pa0, pa1, pa2, pa3);                            \
            SBAR(); pv_tile<B>(o, vb0, pa0, pa1, pa2, pa3);                                                        \
            if (EXIT) wdone = __all(C < -160.f); } }                                                              \
        if (EXIT) { if (lane == 0) flags[((t) & 1) * 8 + wid] = wdone ? 1u : 0u; }                                 \
        if ((t) + 1 < NT) { VMW(); SWRITE_H((B) ^ 1); if ((t) + 2 < NT) SLOAD_H(cur.K, cur.V, KBASE((t) + 2)); }  \
        __syncthreads(); } while (0)
    for (int t = 0; t < NT; t += 2) {
        SB_STEP(t, 0);
        SB_STEP(t + 1, 1);
        if (EXIT) { unsigned a = 1u;
#pragma unroll
            for (int w = 0; w < 8; ++w) a &= flags[8 + w];
            if (a) break; }
    }
    VMW();
    char* Ow = (char*)cur.O + (size_t)(wid * QBLK) * OS * 2; const unsigned ooff = (unsigned)(4 * hi * OS + r32) * 2u;
#pragma unroll
    for (int r = 0; r < 16; ++r) { const int orow0 = (r & 3) + 8 * (r >> 2);
#pragma unroll
        for (int d0 = 0; d0 < 4; ++d0) { const float v = o[d0][r];
            const float vn = shx(v, 1);
            if ((r32 & 1) == 0) *(unsigned*)(Ow + (size_t)(orow0 * OS + d0 * 32) * 2 + ooff) = cvtpk(v, vn); } }
    __syncthreads();
#undef KBASE
#undef SB_STEP
}
}
namespace att2 {
using att::f32x16; using att::s16x4; using att::u32x4; using att::cvtpk; using att::crow;
constexpr int STG = 32768, K2_OFF = 8192, V_OFF = 16384;
constexpr int LDS_WS = 131072 + 512, LDS_LUT = LDS_WS + 2048, LDS_END = LDS_LUT + 2 * 272 * 4;
constexpr float SCALE = att::SCALE, C2 = 1.4426950408889634f * SCALE;
#define SBAR() __builtin_amdgcn_sched_barrier(0)
#define A2_WAITV(n) asm volatile("s_waitcnt vmcnt(" #n ")" ::: "memory")
#define A2_BAR() do { asm volatile("s_waitcnt lgkmcnt(0)" ::: "memory"); __builtin_amdgcn_s_barrier(); asm volatile("" ::: "memory"); } while (0)
__device__ __forceinline__ void bias_mask16(f32x16& p, int dq, const LAS float* lut) {
    const float NEG = -__builtin_inff();
    const LAS float* lp = lut + 64 + dq;
    float bv[16];
#pragma unroll
    for (int r = 0; r < 16; ++r) { const int c = (r & 3) + 8 * (r >> 2); bv[r] = lp[-c]; }
#pragma unroll
    for (int r = 0; r < 16; ++r) { const int c = (r & 3) + 8 * (r >> 2); p[r] = (dq - c >= 0) ? p[r] + bv[r] : NEG; }
}
__device__ __forceinline__ void partialSM16(f32x16& p, float& m_reg, float& alpha, float bo) {
    constexpr float THR = 8.f;
    float pmax = p[0];
#pragma unroll
    for (int r = 1; r < 16; ++r) pmax = fmaxf(pmax, p[r]);
    { auto rr = __builtin_amdgcn_permlane32_swap(__float_as_uint(pmax), __float_as_uint(pmax), false, false); pmax = fmaxf(__uint_as_float(rr[0]), __uint_as_float(rr[1])); }
    pmax += bo;
    float mn;
    if (__builtin_expect(__all((pmax - m_reg) * SCALE <= THR), 1)) { mn = m_reg; alpha = 1.f; }
    else { mn = fmaxf(m_reg, pmax); alpha = __builtin_amdgcn_exp2f((m_reg - mn) * C2); m_reg = mn; }
    const float mnL = (bo - mn) * C2;
#pragma unroll
    for (int r = 0; r < 16; ++r) p[r] = fmaf(p[r], C2, mnL);
}
__device__ __forceinline__ void finishSM16(f32x16& p, float alpha, float& l_reg, bf16x8& pa0, bf16x8& pa1) {
#pragma unroll
    for (int r = 0; r < 16; ++r) p[r] = __builtin_amdgcn_exp2f(p[r]);
    float ps = 0.f;
#pragma unroll
    for (int r = 0; r < 16; ++r) ps += p[r];
    { auto rr = __builtin_amdgcn_permlane32_swap(__float_as_uint(ps), __float_as_uint(ps), false, false); ps = __uint_as_float(rr[0]) + __uint_as_float(rr[1]); }
    l_reg = l_reg * alpha + ps;
    PK4(p, 0, pa0); PK4(p, 8, pa1);
}
#define KRD(dst, addr, off) asm volatile("ds_read_b128 %0, %1 offset:%2" : "=&v"(dst) : "v"(addr), "i"(off) : "memory")
#define KWAIT(n, dst) asm volatile("s_waitcnt lgkmcnt(" #n ")" : "+v"(dst) :: "memory")
__device__ __forceinline__ void qkt16_exp(f32x16& px, f32x16& py, int kb, const int (&kofs)[4], const bf16x8* qr) {
    bf16x8 k0, k1;
    KRD(k0, kb + kofs[0], 0); KRD(k1, kb + kofs[1], 0);
    px = f32x16{};
#define EX2(i) do { py[2 * (i)] = __builtin_amdgcn_exp2f(py[2 * (i)]); py[2 * (i) + 1] = __builtin_amdgcn_exp2f(py[2 * (i) + 1]); } while (0)
    KWAIT(1, k0); px = __builtin_amdgcn_mfma_f32_32x32x16_bf16(k0, qr[0], px, 0, 0, 0); KRD(k0, kb + kofs[2], 0);   EX2(0); SBAR();
    KWAIT(1, k1); px = __builtin_amdgcn_mfma_f32_32x32x16_bf16(k1, qr[1], px, 0, 0, 0); KRD(k1, kb + kofs[3], 0);   EX2(1); SBAR();
    KWAIT(1, k0); px = __builtin_amdgcn_mfma_f32_32x32x16_bf16(k0, qr[2], px, 0, 0, 0); KRD(k0, kb + kofs[0], 128); EX2(2); SBAR();
    KWAIT(1, k1); px = __builtin_amdgcn_mfma_f32_32x32x16_bf16(k1, qr[3], px, 0, 0, 0); KRD(k1, kb + kofs[1], 128); EX2(3); SBAR();
    KWAIT(1, k0); px = __builtin_amdgcn_mfma_f32_32x32x16_bf16(k0, qr[4], px, 0, 0, 0); KRD(k0, kb + kofs[2], 128); EX2(4); SBAR();
    KWAIT(1, k1); px = __builtin_amdgcn_mfma_f32_32x32x16_bf16(k1, qr[5], px, 0, 0, 0); KRD(k1, kb + kofs[3], 128); EX2(5); SBAR();
    KWAIT(1, k0); px = __builtin_amdgcn_mfma_f32_32x32x16_bf16(k0, qr[6], px, 0, 0, 0); EX2(6); SBAR();
    KWAIT(0, k1); px = __builtin_amdgcn_mfma_f32_32x32x16_bf16(k1, qr[7], px, 0, 0, 0); EX2(7); SBAR();
#undef EX2
}
__device__ __forceinline__ void finish_pack16(f32x16& p, float alpha, float& l_reg, bf16x8& pa0, bf16x8& pa1) {
    float ps = 0.f;
#pragma unroll
    for (int r = 0; r < 16; ++r) ps += p[r];
    { auto rr = __builtin_amdgcn_permlane32_swap(__float_as_uint(ps), __float_as_uint(ps), false, false); ps = __uint_as_float(rr[0]) + __uint_as_float(rr[1]); }
    l_reg = l_reg * alpha + ps;
    PK4(p, 0, pa0); PK4(p, 8, pa1);
}
__device__ __forceinline__ void qkt16(f32x16& p, const char* sb, const int (&kofs)[4], const bf16x8* qr) {
    p = f32x16{};
#pragma unroll
    for (int d0 = 0; d0 < 8; ++d0) { const bf16x8 kf = *reinterpret_cast<const bf16x8*>(sb + kofs[d0 & 3] + (d0 >> 2) * 128);
        p = __builtin_amdgcn_mfma_f32_32x32x16_bf16(kf, qr[d0], p, 0, 0, 0); }
}
__device__ __forceinline__ void pv16(f32x16* o, int vb, bf16x8 pa0, bf16x8 pa1) {
#define TRRD(dst, off) asm volatile("ds_read_b64_tr_b16 %0, %1 offset:%2" : "=&v"(dst) : "v"(vb), "i"(off) : "memory")
#define RD4(S, d0) do { TRRD(S##l0, (d0) * 512); TRRD(S##h0, (d0) * 512 + 4096); TRRD(S##l1, (d0) * 512 + 8192); TRRD(S##h1, (d0) * 512 + 12288); } while (0)
#define MM2(S, d0) do { o[d0] = __builtin_amdgcn_mfma_f32_32x32x16_bf16(pa0, (bf16x8){S##l0[0], S##l0[1], S##l0[2], S##l0[3], S##h0[0], S##h0[1], S##h0[2], S##h0[3]}, o[d0], 0, 0, 0);   \
        o[d0] = __builtin_amdgcn_mfma_f32_32x32x16_bf16(pa1, (bf16x8){S##l1[0], S##l1[1], S##l1[2], S##l1[3], S##h1[0], S##h1[1], S##h1[2], S##h1[3]}, o[d0], 0, 0, 0); } while (0)
#define WAITL(n) asm volatile("s_waitcnt lgkmcnt(" #n ")" ::: "memory")
    s16x4 Al0, Ah0, Al1, Ah1, Bl0, Bh0, Bl1, Bh1;
    RD4(A, 0);
    RD4(B, 1); WAITL(4); SBAR(); MM2(A, 0); SBAR();
    RD4(A, 2); WAITL(4); SBAR(); MM2(B, 1); SBAR();
    RD4(B, 3); WAITL(4); SBAR(); MM2(A, 2); SBAR();
    RD4(A, 4); WAITL(4); SBAR(); MM2(B, 3); SBAR();
    RD4(B, 5); WAITL(4); SBAR(); MM2(A, 4); SBAR();
    RD4(A, 6); WAITL(4); SBAR(); MM2(B, 5); SBAR();
    RD4(B, 7); WAITL(4); SBAR(); MM2(A, 6); SBAR();
    WAITL(0); SBAR(); MM2(B, 7);
#undef RD4
#undef MM2
#undef WAITL
#undef TRRD
}
template <int LD, int OLD>
__device__ __forceinline__ void diff_unit(const bf16* QKVb, bf16* Ob, int h, int P0, LAS unsigned char* ldsl, int tid, float lam, float oml, const float* subln, float bfar) {
    char* lds = (char*)ldsl;
    asm volatile("" : "+v"(tid));
    const int wid = __builtin_amdgcn_readfirstlane(tid >> 6), lane = tid & 63, r32 = lane & 31, hi = lane >> 5, rg = wid & 3, mp = wid >> 2;
    const int qlo = P0 + 32 * rg, qm = qlo + r32 - 4 * hi;
    const int NS = P0 / 32 + 4;
    float* wsf = (float*)(lds + LDS_WS) + wid * 64; float* li_l = wsf, * al_l = wsf + 32;
    const LAS float* lut = (const LAS float*)(ldsl + LDS_LUT) + mp * 272;
    bf16x8 qr[8];
    { const char* qb = (const char*)(QKVb + (size_t)qlo * LD + (2 * h + mp) * 128); const unsigned qoff = (unsigned)(r32 * LD + hi * 8) * 2u;
#pragma unroll
      for (int d0 = 0; d0 < 8; ++d0) qr[d0] = *(const bf16x8*)(qb + d0 * 32 + qoff); }
    unsigned koff, voff;
    { const int r = 4 * wid + (lane >> 4), c = (lane & 15) ^ (r & 7); koff = (unsigned)(r * LD + c * 8) * 2u;
      const int s = 2 * wid + (lane >> 5), kg = s >> 3, cb = s & 7, rr = (lane >> 2) & 7, q = lane & 3, kk = kg * 8 + rr, k = (kk & ~0xC) | ((kk & 4) << 1) | ((kk & 8) >> 1);
      voff = (unsigned)(k * LD + cb * 32 + q * 8) * 2u; }
    const char* Kg = (const char*)(QKVb + 2048 + (2 * h) * 128); const char* Vg = (const char*)(QKVb + 4096 + h * 256);
#define A2_DMA(u) do { if (mp == 0) { const size_t ro_ = (size_t)(u) * 32 * LD * 2; LAS unsigned char* sb_ = ldsl + ((u) & 3) * STG + wid * 1024;                  \
        __builtin_amdgcn_global_load_lds((const unsigned*)(Kg + ro_ + koff), (LAS unsigned*)(sb_), 16, 0, 0);                                                           \
        __builtin_amdgcn_global_load_lds((const unsigned*)(Kg + ro_ + 256 + koff), (LAS unsigned*)(sb_ + K2_OFF), 16, 0, 0);                                            \
        __builtin_amdgcn_global_load_lds((const unsigned*)(Vg + ro_ + voff), (LAS unsigned*)(sb_ + V_OFF), 16, 0, 0);                                                   \
        __builtin_amdgcn_global_load_lds((const unsigned*)(Vg + ro_ + (size_t)16 * LD * 2 + voff), (LAS unsigned*)(sb_ + V_OFF + 8192), 16, 0, 0);                       \
                      \
        __builtin_amdgcn_global_load_lds((const unsigned*)(Kg + ro_ + (size_t)16 * LD * 2 + koff), (LAS unsigned*)(sb_ + 4096), 16, 0, 0);                               \
        __builtin_amdgcn_global_load_lds((const unsigned*)(Kg + ro_ + (size_t)16 * LD * 2 + 256 + koff), (LAS unsigned*)(sb_ + 4096 + K2_OFF), 16, 0, 0);                \
        __builtin_amdgcn_global_load_lds((const unsigned*)(Vg + ro_ + (size_t)4 * LD * 2 + voff), (LAS unsigned*)(sb_ + 4096 + V_OFF), 16, 0, 0);                        \
        __builtin_amdgcn_global_load_lds((const unsigned*)(Vg + ro_ + (size_t)20 * LD * 2 + voff), (LAS unsigned*)(sb_ + 4096 + V_OFF + 8192), 16, 0, 0); } } while (0)
    int kofs[4];
#pragma unroll
    for (int dd = 0; dd < 4; ++dd) kofs[dd] = mp * K2_OFF + KSWZ(r32, (dd * 16 + hi * 8) * 2);
    const int vb0 = (int)(uintptr_t)lds + V_OFF + att::v_rd_base(lane);
    float m_reg = -1e30f, l_reg = 0.f; f32x16 o[8] = {};
    f32x16 pA, pB; float alA, alB; bf16x8 pa0, pa1;
#define RESC(a) do { if (__any((a) < 1.f)) { if (hi == 0) al_l[r32] = (a); asm volatile("s_waitcnt lgkmcnt(0)" ::: "memory");              \
                     for (int d_ = 0; d_ < 8; ++d_) for (int r = 0; r < 16; ++r) o[d_][r] *= al_l[crow(r, hi)]; } } while (0)
#define NEAR(u) ((u) * 32 + 144 > qlo)
#define SM_PART(PX, alX, u) do { if (NEAR(u)) bias_mask16(PX, qm - (u) * 32, lut); partialSM16(PX, m_reg, alX, NEAR(u) ? 0.f : bfar); } while (0)
    A2_DMA(0); A2_DMA(1);
    A2_WAITV(8); A2_BAR();
    A2_DMA(2);
    SBAR(); qkt16(pA, lds, kofs, qr);
    SM_PART(pA, alA, 0);
#define STEP(PX, alX, PY, alY, u) do {                                                                       \
        if ((u) + 1 < NS) A2_WAITV(8); else A2_WAITV(0);                                                      \
        A2_BAR();                                                                                            \
        if ((u) + 2 < NS) A2_DMA((u) + 2);                                                                   \
        SBAR(); qkt16_exp(PX, PY, (int)(uintptr_t)lds + ((u) & 3) * STG, kofs, qr);                            \
        finish_pack16(PY, alY, l_reg, pa0, pa1); SBAR();                                                     \
        pv16(o, vb0 + (((u) - 1) & 3) * STG, pa0, pa1);                                                       \
        SM_PART(PX, alX, u);                                                                                 \
        RESC(alX); } while (0)
    for (int u = 1; u + 1 < NS; u += 2) {
        STEP(pB, alB, pA, alA, u);
        STEP(pA, alA, pB, alB, u + 1);
    }
    STEP(pB, alB, pA, alA, NS - 1);
    finishSM16(pB, alB, l_reg, pa0, pa1); SBAR();
    pv16(o, vb0 + ((NS - 1) & 3) * STG, pa0, pa1);
    if (hi == 0) li_l[r32] = l_reg;
    asm volatile("s_waitcnt lgkmcnt(0)" ::: "memory");
    float rli[16];
#pragma unroll
    for (int r = 0; r < 16; ++r) rli[r] = __builtin_amdgcn_rcpf(li_l[crow(r, hi)]);
    A2_BAR();
    float* xch = (float*)(lds + rg * 32768);
    if (mp == 1) {
#pragma unroll
        for (int r = 0; r < 16; ++r) { const float f = lam * rli[r];
#pragma unroll
            for (int d0 = 0; d0 < 8; ++d0) xch[crow(r, hi) * 256 + d0 * 32 + r32] = o[d0][r] * f; }
    }
    A2_BAR();
    if (mp == 0) {
        int lane_e = lane; asm volatile("" : "+v"(lane_e)); const int r32e = lane_e & 31;
        float ssq[16];
#pragma unroll
        for (int r = 0; r < 16; ++r) { float s = 0.f;
#pragma unroll
            for (int d0 = 0; d0 < 8; ++d0) { const float v = o[d0][r] * rli[r] - xch[crow(r, hi) * 256 + d0 * 32 + r32]; o[d0][r] = v; s += v * v; }
            ssq[r] = s; }
#pragma unroll
        for (int st = 1; st < 32; st <<= 1) {
#pragma unroll
            for (int r = 0; r < 16; ++r) ssq[r] += __int_as_float(__builtin_amdgcn_ds_bpermute((lane_e ^ st) << 2, __float_as_int(ssq[r]))); }
        float g[8];
#pragma unroll
        for (int d0 = 0; d0 < 8; ++d0) g[d0] = subln[d0 * 32 + r32e] * oml;
        char* Ow = (char*)(Ob + (size_t)qlo * OLD + h * 256); const unsigned ooff = (unsigned)(4 * hi * OLD + r32e) * 2u;
#pragma unroll
        for (int r = 0; r < 16; ++r) { const float rs = __builtin_amdgcn_rsqf(ssq[r] * (1.0f / 256.0f) + 1e-6f); const int orow0 = (r & 3) + 8 * (r >> 2);
#pragma unroll
            for (int d0 = 0; d0 < 8; ++d0) { const float v = o[d0][r] * rs * g[d0]; const float vn = __int_as_float(__builtin_amdgcn_ds_bpermute((lane_e ^ 1) << 2, __float_as_int(v)));
                if ((r32 & 1) == 0) *(unsigned*)(Ow + (size_t)(orow0 * OLD + d0 * 32) * 2 + ooff) = cvtpk(v, vn); } }
    }
    A2_WAITV(0); A2_BAR();
#undef A2_DMA
#undef RESC
#undef NEAR
#undef SM_PART
#undef STEP
}
#undef SBAR
}
template <bool EXIT>
__device__ __forceinline__ void attnB_phase(Frame& F, const bf16* Q, const bf16* KV, bf16* O) {
    int tid = CUR_TID(F);
    char* lds = (char*)(F.lds + RING_OFF);
    int vc0 = F.vcu; asm volatile("" : "+s"(vc0));
    for (int vc = vc0; vc < 256; vc += F.G) {
        const int bh = vc >> 3, p = vc & 7, b = bh >> 4, h = bh & 15;
        const bf16* Qb = Q + (size_t)b * SEQ * DM + h * 128; const bf16* Kb = KV + (size_t)b * SEQ * NKV + h * 128; const bf16* Vb = Kb + DM;
        bf16* Ob = O + (size_t)b * SEQ * DM + h * 128;
        for (int i = 0; i < 4; ++i) {
            const int qb = ((i >> 1) << 4) + ((i & 1) ? 15 - p : p);
            const att::BlockRef cur{Qb + (size_t)qb * 256 * DM, Kb, Vb, Ob + (size_t)qb * 256 * DM, qb * 256};
            att::sb_block<DM, NKV, NKV, DM, EXIT>(cur, lds, tid);
        }
    }
}

__device__ __forceinline__ void attnA2_phase(Frame& F, const bf16* QKV, bf16* O, const float* rel_bias, const float* lamv, const float* subln, int layer) {
    int tid = CUR_TID(F);
    const int lane = tid & 63;
    asm volatile("" : "+s"(layer)); const float lambda_init = layer == 0 ? 0.2f : 0.35550906759096924f;
    float s01 = 0.f, s23 = 0.f;
    for (int i = lane; i < 128; i += 64) { s01 += lamv[i] * lamv[128 + i]; s23 += lamv[256 + i] * lamv[384 + i]; }
    s01 = wave_sum(s01); s23 = wave_sum(s23);
    const float lam = expf(s01) - expf(s23) + lambda_init, oml = 1.0f - lambda_init;
    int vc0 = F.vcu; asm volatile("" : "+s"(vc0));
    for (int vc = vc0; vc < 256; vc += F.G) {
        const int bh = vc >> 4, p = vc & 15, b = bh >> 3, h = bh & 7;
        __syncthreads();
        asm volatile("" : "+v"(tid));
        { LAS float* lut = (LAS float*)(F.lds + att2::LDS_LUT);
          for (int i = tid; i < 2 * 272; i += 512) { const int mpi = i >= 272 ? 1 : 0; int n = i - mpi * 272 - 64; n = n < 0 ? 0 : n; lut[i] = rel_bias[t5_bucket(n) * 16 + 2 * h + mpi] * (1.0f / att::SCALE); } }
        const float bfar = rel_bias[31 * 16 + 2 * h + (tid >> 8)] * (1.0f / att::SCALE);
        __syncthreads();
        const bf16* QKVb = QKV + (size_t)b * SEQ * NQKV; bf16* Ob = O + (size_t)b * SEQ * DM;
        for (int i = 0; i < 4; ++i) {
            const int qb = ((i >> 1) << 5) + ((i & 1) ? 31 - p : p);
            att2::diff_unit<NQKV, DM>(QKVb, Ob, h, qb * 128, F.lds, tid, lam, oml, subln, bfar);
        }
    }
}

typedef const __attribute__((address_space(4))) Args* KArgs;
#define KARG() ({ KArgs ap_ = (KArgs)__builtin_amdgcn_kernarg_segment_ptr(); asm volatile("" : "+s"(ap_)); ap_; })
#define IN(k) (KARG()->in[k])
#define WS() (KARG()->ws)
__global__ void __launch_bounds__(NWAVES * 64, 2) mk_fwd(Args args_unused) {
    extern __shared__ __attribute__((aligned(16))) unsigned char lds[];
    Frame F;
    F.lds = (LAS unsigned char*)lds;
    F.MISC = (volatile LAS unsigned*)(F.lds + MISC_OFF);
    F.wave = __builtin_amdgcn_readfirstlane((int)threadIdx.x >> 6);
    F.G = gridDim.x; { const int bx = blockIdx.x; F.vcu = (F.G % 8 == 0) ? (bx % 8) * (F.G / 8) + bx / 8 : bx; }
    F.ctl = (gu32*)(WS() + WS_CTL);
    for (int u = threadIdx.x; u < (LDS_BYTES - LDSCTL_OFF) / 4; u += NWAVES * 64) ((LAS unsigned*)(F.lds + LDSCTL_OFF))[u] = 0u;
    __syncthreads();
    (void)xcd_barrier_post((unsigned*)(F.ctl + CW_BAR), F.MISC + 8);
#define GRID_BAR() do { XcdBarrier b_; b_.bar = (unsigned*)(WS() + WS_CTL) + CW_BAR; b_.x = xb_xcc_id(); b_.st = F.MISC + 8; b_.tid = CUR_TID(F); xcd_barrier(b_); } while (0)
#define XO() (KARG()->out)
#define WSP(off) ((bf16*)(WS() + (off)))
#define XN WSP(WS_XN)
#define OB WSP(WS_OB)
#define HB WSP(WS_H)
#define QKV WSP(WS_QKV)
#define KVSH WSP(WS_KVSH)

#define SSV(v) ((float*)(WS() + WS_SS) + (size_t)(v) * M * 32)
#define RSTAB ((PG8_LAS float*)(F.lds + RSTD_OFF))
    {
        LAS float* scr = (LAS float*)(F.lds + RING_OFF + F.wave * 16384);
        transpose_group<true >(F, F.vcu, F.G, IN(2), IN(1), 4, DM, NWI, (bf16*)(WS() + WS_WI_PRE), scr);
        transpose_group<true >(F, F.vcu, F.G, IN(6), IN(5), 4, DM, NWI, (bf16*)(WS() + WS_WI_POST), scr);
        transpose_group<false>(F, F.vcu, F.G, IN(9), IN(4), 2, DM, NQKV, (bf16*)(WS() + WS_AWQKV), scr);
        transpose_group<false>(F, F.vcu, F.G, IN(16), IN(15), 1, DM, NKV, (bf16*)(WS() + WS_BWKV), scr);
        cast_rows(F, IN(0), XN, SSV(0));
    }
    GRID_BAR();

    for (int l = 0; l < 4; ++l) {
        if (l == 2) {
            pg8::Gemm g{XN, (const bf16*)(WS() + WS_BWKV), M, NKV, DM}; pg8::StaticOrder S; S.init(M, NKV, F.G, (int)blockIdx.x);
            pg8::preload_rstd(S, SSV(6), RSTAB, CUR_TID(F));
            pg8::EpiBf16 E{KVSH, NKV, RSTAB};
            pg8::gemm_phase<pg8::EpiBf16, pg8::StaticOrder, true, true>(F.lds + RING_OFF, g, S, E, CUR_TID(F));
        }
        for (int s = 0; s < 2; ++s) {
            {
                const bf16* wi = (const bf16*)(WS() + (s ? WS_WI_POST : WS_WI_PRE) + (size_t)l * SZ_WI);
                pg8::Gemm g{XN, wi, M, NWI, DM}; pg8::StaticOrder S; S.init(M, NWI, F.G, (int)blockIdx.x);
                pg8::preload_rstd(S, SSV(3 * l + 2 * s), RSTAB, CUR_TID(F));
                pg8::EpiSwiGLU E{HB, DFF, RSTAB};
                pg8::gemm_phase<pg8::EpiSwiGLU, pg8::StaticOrder, true, true>(F.lds + RING_OFF, g, S, E, CUR_TID(F));
            }
            {
                const int rem_ = ((M / 256) * (NWI / 256)) % F.G, c_ = (int)blockIdx.x;
                if (rem_ == 0 || c_ >= rem_) {
                    const int part_ = rem_ ? c_ - rem_ : F.vcu, nparts_ = rem_ ? F.G - rem_ : F.G;
                    LAS float* scr = (LAS float*)(F.lds + RING_OFF + F.wave * 16384);
                    transpose_group<false>(F, part_, nparts_, (s ? IN(7) : IN(3)) + (size_t)l * DFF * DM, nullptr, 1, DFF, DM, (bf16*)(WS() + (s ? WS_WO_POST : WS_WO_PRE) + (size_t)l * SZ_WO), scr);
                    const float* xw = nullptr; const float* xg = nullptr; bf16* xd = nullptr; float xs = 1.0f;
                    if (s == 0) { if (l < 2) { xw = IN(14) + (size_t)l * DM * DM; xd = (bf16*)(WS() + WS_AWO + (size_t)l * SZ_DD); } else { xw = IN(18) + (size_t)(l - 2) * DM * DM; xd = (bf16*)(WS() + WS_BWO + (size_t)(l - 2) * SZ_DD); } }
                    else if (l == 1 || l == 2) { xw = IN(17) + (size_t)(l - 1) * DM * DM; xg = IN(4) + (size_t)(l + 1) * DM; xd = (bf16*)(WS() + WS_BWQ + (size_t)(l - 1) * SZ_DD); xs = att::SCALE * 1.4426950408889634f; }
                    if (xw) transpose_group<false>(F, part_, nparts_, xw, xg, 1, DM, DM, xd, scr, xs);
                }
            }
            GRID_BAR();
            {
                const bf16* wo = (const bf16*)(WS() + (s ? WS_WO_POST : WS_WO_PRE) + (size_t)l * SZ_WO);
                pg8::Gemm g{HB, wo, M, DM, DFF}; pg8::StaticOrder S; S.init(M, DM, F.G, (int)blockIdx.x);
                if (l == 3 && s == 1) {
                    pg8::EpiResid16<true> E{XN, nullptr, XO(), DM, 0.5f};
                    pg8::gemm_phase<pg8::EpiResid16<true>, pg8::StaticOrder, true, true>(F.lds + RING_OFF, g, S, E, CUR_TID(F));
                } else {
                    pg8::EpiResid16<false> E{XN, SSV(3 * l + 2 * s + 1), nullptr, DM, 0.5f};
                    pg8::gemm_phase<pg8::EpiResid16<false>, pg8::StaticOrder, false, true>(F.lds + RING_OFF, g, S, E, CUR_TID(F));
                }
            }
            GRID_BAR();
            if (s == 0) {
                if (l < 2) {
                    { LAS float* gl = (LAS float*)(F.lds + QKG_OFF); const int t_ = CUR_TID(F);
                      if (t_ < 256) gl[t_] = (t_ < 128 ? IN(10) + (size_t)l * HD : IN(11) + (size_t)l * HD - 128)[t_]; }
                    pg8::Gemm g{XN, (const bf16*)(WS() + WS_AWQKV + (size_t)l * SZ_AWQKV), M, NQKV, DM}; pg8::StaticOrder S; S.init(M, NQKV, F.G, (int)blockIdx.x);
                    pg8::preload_rstd(S, SSV(3 * l + 1), RSTAB, CUR_TID(F));
                    pg8::EpiQKV E{QKV, NQKV, (PG8_LAS float*)(F.lds + QKX_OFF), (const PG8_LAS float*)(F.lds + QKG_OFF), RSTAB};
                    pg8::gemm_phase<pg8::EpiQKV, pg8::StaticOrder, true, true>(F.lds + RING_OFF, g, S, E, CUR_TID(F));
                } else {
                    pg8::Gemm g{XN, (const bf16*)(WS() + WS_BWQ + (size_t)(l - 2) * SZ_DD), M, DM, DM}; pg8::StaticOrder S; S.init(M, DM, F.G, (int)blockIdx.x);
                    pg8::preload_rstd(S, SSV(3 * l + 1), RSTAB, CUR_TID(F));
                    pg8::EpiBf16 E{QKV, DM, RSTAB};
                    pg8::gemm_phase<pg8::EpiBf16, pg8::StaticOrder, true, true>(F.lds + RING_OFF, g, S, E, CUR_TID(F));
                }
                GRID_BAR();
                if (l < 2) {
                    attnA2_phase(F, QKV, OB, IN(8), IN(12) + (size_t)l * 512, IN(13) + (size_t)l * 256, l);
                } else {
                    attnB_phase<true>(F, QKV, KVSH, OB);
                }
                GRID_BAR();
                {
                    const bf16* w = (l < 2) ? (const bf16*)(WS() + WS_AWO + (size_t)l * SZ_DD) : (const bf16*)(WS() + WS_BWO + (size_t)(l - 2) * SZ_DD);
                    pg8::Gemm g{OB, w, M, DM, DM}; pg8::StaticOrder S; S.init(M, DM, F.G, (int)blockIdx.x);
                    pg8::EpiResid16<false> E{XN, SSV(3 * l + 2), nullptr, DM, 1.0f};
                    pg8::gemm_phase<pg8::EpiResid16<false>, pg8::StaticOrder, false, true>(F.lds + RING_OFF, g, S, E, CUR_TID(F));
                }
                GRID_BAR();
            }
        }
    }
#undef SSV
#undef RSTAB
#undef GRID_BAR
#undef XN
#undef OB
#undef HB
#undef QKV
#undef KVSH
}

extern "C" void kernel_launch(void* const* d_in, const int* in_sizes, int n_in, void* d_out, int out_size, void* d_ws, size_t ws_size, hipStream_t stream) {
    static int grid = 0;
    if (grid == 0) {
        if (n_in != 19 || in_sizes[0] != M * DM || out_size != M * DM || ws_size < WS_END) { fprintf(stderr, "kernel_launch: shape/workspace mismatch: n_in %d in0 %d out %d ws %zu (need %zu); nothing launched\n", n_in, n_in > 0 ? in_sizes[0] : -1, out_size, ws_size, (size_t)WS_END); grid = -1; return; }
        int dev = 0, cus = 0, per_cu = 0;
        if (hipGetDevice(&dev) != hipSuccess || hipDeviceGetAttribute(&cus, hipDeviceAttributeMultiprocessorCount, dev) != hipSuccess) { fprintf(stderr, "kernel_launch: device query failed\n"); grid = -1; return; }
        if (hipFuncSetAttribute((const void*)mk_fwd, hipFuncAttributeMaxDynamicSharedMemorySize, LDS_BYTES) != hipSuccess) { fprintf(stderr, "kernel_launch: hipFuncSetAttribute failed\n"); grid = -1; return; }
        if (hipOccupancyMaxActiveBlocksPerMultiprocessor(&per_cu, (const void*)mk_fwd, NWAVES * 64, LDS_BYTES) != hipSuccess || per_cu < 1)
            fprintf(stderr, "kernel_launch: note: occupancy query reports %d workgroups per CU\n", per_cu);
        (void)hipGetLastError();
        grid = cus;
    }
    if (grid < 0) return;
    if (hipMemsetAsync((char*)d_ws + WS_CTL, 0, CTL_ZERO_BYTES, stream) != hipSuccess) { fprintf(stderr, "kernel_launch: memset failed\n"); return; }
    Args a{};
    for (int i = 0; i < 19; ++i) a.in[i] = (const float*)d_in[i];
    a.out = (float*)d_out; a.ws = (unsigned char*)d_ws;
    hipLaunchKernelGGL(mk_fwd, dim3(grid), dim3(NWAVES * 64), LDS_BYTES, stream, a);
    const hipError_t le = hipPeekAtLastError();
    if (le != hipSuccess) fprintf(stderr, "kernel_launch: launch failed: %s\n", hipGetErrorName(le));
}
```

```cpp
#include <hip/hip_runtime.h>
__device__ __forceinline__ int lane_id() { unsigned z; asm volatile("s_mov_b32 %0, 0" : "=s"(z)); return (int)__builtin_amdgcn_mbcnt_hi(~0u, __builtin_amdgcn_mbcnt_lo(~0u, z)); }
__device__ __forceinline__ float shx(float v, int o) { return __int_as_float(__builtin_amdgcn_ds_bpermute((lane_id() ^ o) << 2, __float_as_int(v))); }
#include <hip/hip_runtime.h>
#include <cstdio>
#include <cstdint>
namespace pg8 {
#define PG8_LAS __attribute__((address_space(3)))
typedef unsigned short bf16_t;
typedef short bf16x8 __attribute__((ext_vector_type(8)));
typedef float f32x4 __attribute__((ext_vector_type(4)));
typedef unsigned u32x4 __attribute__((ext_vector_type(4)));
constexpr int BM = 256, BK = 64, HALF = 128, HTB = HALF * BK * 2  , STAGE_BYTES = 8 * HTB, NXCD = 8, WGM = 8;

__host__ __device__ __forceinline__ int lds_byte(int r, int c) { const int st = (r >> 4) * 2 + (c >> 5), rr = r & 15, cc = c & 31, ob = rr * 64 + cc * 2; return st * 1024 + (ob ^ (((ob >> 9) & 1) << 5)); }
__host__ __device__ __forceinline__ void stage_rc(int b, int& R, int& C) { const int st = b / 1024, sb = b % 1024, swz = sb ^ (((sb >> 9) & 1) << 5); R = (st >> 1) * 16 + swz / 64; C = (st & 1) * 32 + (swz % 64) / 2; }
__host__ __device__ __forceinline__ int perm32(int rho) { const int n = rho >> 4, i = rho & 15; return 8 * (i >> 2) + 4 * n + (i & 3); }

struct Unit { int pm, pn, idx; };
struct Gemm { const bf16_t* A; const bf16_t* Bt; int M, N, K; };

struct StaticOrder {
    int nM, nN, nwg, G, c;
    __host__ __device__ void init(int M, int N, int G_, int c_) { nM = M / BM; nN = N / BM; nwg = nM * nN; G = G_; c = c_; }
    __host__ __device__ bool next(int i, Unit& u) const {
        const long L = (long)i * G + c; if (L >= nwg) return false;
        int wgid = (int)L; { const int q = nwg / NXCD, r = nwg % NXCD, xcd = wgid % NXCD, off = wgid / NXCD; wgid = (xcd < r ? xcd * (q + 1) : r * (q + 1) + (xcd - r) * q) + off; }
        const int nig = WGM * nN, gid = wgid / nig, fm = gid * WGM, gsz = (nM - fm) < WGM ? (nM - fm) : WGM;
        u.pm = fm + ((wgid % nig) % gsz); u.pn = (wgid % nig) / gsz; u.idx = i; return true;
    }
    __device__ __forceinline__ void a_ready(const Unit&) const {}
    __device__ __forceinline__ void done(const Unit&) const {}
};

__device__ __forceinline__ unsigned cvt_pk_bf16(float lo, float hi) { unsigned r; asm volatile("v_cvt_pk_bf16_f32 %0, %1, %2" : "=v"(r) : "v"(lo), "v"(hi)); return r; }
template <class Sched>
__device__ __forceinline__ void preload_rstd(const Sched& S, const float* ss, PG8_LAS float* rs, int tid) {
    Unit u; const int sub = tid & 7, r0 = tid >> 3;
    int pm_have = -1; float val[4] = {0.f, 0.f, 0.f, 0.f};
    for (int i = 0; S.next(i, u); ++i) {
        if (u.pm != pm_have) {
            pm_have = u.pm;
#pragma unroll
            for (int j = 0; j < 4; ++j) {
                const f32x4 a = *(const f32x4*)(ss + (size_t)(u.pm * BM + r0 + 64 * j) * 32 + sub * 4); float s = (a[0] + a[1]) + (a[2] + a[3]);
                s += shx(s, 1); s += shx(s, 2); s += shx(s, 4);
                val[j] = __builtin_amdgcn_rsqf(s * (1.0f / 2048.0f) + 1e-6f); }
        }
        if (sub == 0) {
#pragma unroll
            for (int j = 0; j < 4; ++j) rs[i * 256 + r0 + 64 * j] = val[j]; }
    }
    asm volatile("s_waitcnt lgkmcnt(0)" ::: "memory"); __syncthreads();
}
__device__ __forceinline__ void row_rstd(float (&rs)[2][4], const PG8_LAS float* tab, const Unit& u, int wr, int fr) {
#pragma unroll
    for (int ai = 0; ai < 2; ++ai)
#pragma unroll
        for (int m = 0; m < 4; ++m) rs[ai][m] = tab[u.idx * 256 + ai * HALF + wr * 64 + m * 16 + fr];
}
struct EpiBf16 {
    static constexpr bool PERM = true, AFTER_DRAIN = false;
    bf16_t* O; int ldc; const PG8_LAS float* rstab;
    __device__ __forceinline__ void operator()(const f32x4 (&acc)[2][2][4][2], const Unit& u, int wr, int wc, int fr, int fq) const {
        const int row0 = u.pm * BM + wr * 64 + fr, col0 = u.pn * BM + wc * 32 + 8 * fq;
        float rs[2][4]; row_rstd(rs, rstab, u, wr, fr);
#pragma unroll
        for (int ai = 0; ai < 2; ++ai)
#pragma unroll
            for (int m = 0; m < 4; ++m) { bf16_t* rowp = O + (size_t)(row0 + ai * HALF + m * 16) * ldc + col0; const float r = rs[ai][m];
#pragma unroll
                for (int bj = 0; bj < 2; ++bj) { const f32x4 v0 = acc[ai][bj][m][0] * r, v1 = acc[ai][bj][m][1] * r;
                    u32x4 w; w.x = cvt_pk_bf16(v0[0], v0[1]); w.y = cvt_pk_bf16(v0[2], v0[3]); w.z = cvt_pk_bf16(v1[0], v1[1]); w.w = cvt_pk_bf16(v1[2], v1[3]);
                    *(u32x4*)(rowp + bj * HALF) = w; } }
    }
};
struct EpiQKV {
    static constexpr bool PERM = true, AFTER_DRAIN = false;
    bf16_t* O; int ldc; PG8_LAS float* xs; const PG8_LAS float* gains; const PG8_LAS float* rstab;
    __device__ __forceinline__ void operator()(const f32x4 (&acc)[2][2][4][2], const Unit& u, int wr, int wc, int fr, int fq) const {
        const int row0 = u.pm * BM + wr * 64 + fr, col0 = u.pn * BM + wc * 32 + 8 * fq;
        const bool nrm = u.pn < 16;
        float rs[2][4]; row_rstd(rs, rstab, u, wr, fr);
        if (nrm) {
#pragma unroll
            for (int ai = 0; ai < 2; ++ai)
#pragma unroll
                for (int m = 0; m < 4; ++m)
#pragma unroll
                    for (int bj = 0; bj < 2; ++bj) { const f32x4 a = acc[ai][bj][m][0] * rs[ai][m], b = acc[ai][bj][m][1] * rs[ai][m];
                        float s = ((a[0] * a[0] + a[1] * a[1]) + (a[2] * a[2] + a[3] * a[3])) + ((b[0] * b[0] + b[1] * b[1]) + (b[2] * b[2] + b[3] * b[3]));
                        s += shx(s, 16); s += shx(s, 32);
                        if (fq == 0) xs[(((wr * 128 + ai * 64 + m * 16 + fr) * 2 + bj) << 2) + wc] = s; }
        }
        asm volatile("s_waitcnt lgkmcnt(0)" ::: "memory"); __builtin_amdgcn_s_barrier(); asm volatile("" ::: "memory");
        f32x4 g0 = {1.f, 1.f, 1.f, 1.f}, g1 = g0;
        if (nrm) { const PG8_LAS float* gp = gains + (u.pn >= 8 ? 128 : 0) + wc * 32 + 8 * fq; g0 = *(const PG8_LAS f32x4*)gp; g1 = *(const PG8_LAS f32x4*)(gp + 4); }
#pragma unroll
        for (int ai = 0; ai < 2; ++ai)
#pragma unroll
            for (int m = 0; m < 4; ++m) { bf16_t* rowp = O + (size_t)(row0 + ai * HALF + m * 16) * ldc + col0;
#pragma unroll
                for (int bj = 0; bj < 2; ++bj) { f32x4 v0 = acc[ai][bj][m][0] * rs[ai][m], v1 = acc[ai][bj][m][1] * rs[ai][m];
                    if (nrm) { const f32x4 p = *(const PG8_LAS f32x4*)(xs + (((wr * 128 + ai * 64 + m * 16 + fr) * 2 + bj) << 2));
                        const float r = __builtin_amdgcn_rsqf(((p[0] + p[1]) + (p[2] + p[3])) * (1.0f / 128.0f) + 1e-6f); v0 = v0 * r * g0; v1 = v1 * r * g1; }
                    u32x4 w; w.x = cvt_pk_bf16(v0[0], v0[1]); w.y = cvt_pk_bf16(v0[2], v0[3]); w.z = cvt_pk_bf16(v1[0], v1[1]); w.w = cvt_pk_bf16(v1[2], v1[3]);
                    *(u32x4*)(rowp + bj * HALF) = w; } }
    }
};
__device__ __forceinline__ f32x4 silu_mul4(f32x4 g, f32x4 u, float nl, float r2) {
    f32x4 t = g * nl;
    t = (f32x4){__builtin_amdgcn_exp2f(t[0]), __builtin_amdgcn_exp2f(t[1]), __builtin_amdgcn_exp2f(t[2]), __builtin_amdgcn_exp2f(t[3])} + 1.0f;
    t = (f32x4){__builtin_amdgcn_rcpf(t[0]), __builtin_amdgcn_rcpf(t[1]), __builtin_amdgcn_rcpf(t[2]), __builtin_amdgcn_rcpf(t[3])} * r2;
    return (g * u) * t;
}
struct EpiSwiGLU {
    static constexpr bool PERM = true, AFTER_DRAIN = false;
    bf16_t* O; int ldc; const PG8_LAS float* rstab;
    __device__ __forceinline__ void operator()(const f32x4 (&acc)[2][2][4][2], const Unit& u, int wr, int wc, int fr, int fq) const {
        const int row0 = u.pm * BM + wr * 64 + fr, col0 = u.pn * HALF + wc * 32 + 8 * fq;
        float rs[2][4]; row_rstd(rs, rstab, u, wr, fr);
#pragma unroll
        for (int ai = 0; ai < 2; ++ai)
#pragma unroll
            for (int m = 0; m < 4; ++m) { bf16_t* rowp = O + (size_t)(row0 + ai * HALF + m * 16) * ldc + col0; const float r = rs[ai][m], nl = r * -1.4426950408889634f, r2 = r * r;
                const f32x4 g0 = acc[ai][0][m][0], g1 = acc[ai][0][m][1], u0 = acc[ai][1][m][0], u1 = acc[ai][1][m][1];
                const f32x4 h0 = silu_mul4(g0, u0, nl, r2), h1 = silu_mul4(g1, u1, nl, r2);
                u32x4 w; w.x = cvt_pk_bf16(h0[0], h0[1]); w.y = cvt_pk_bf16(h0[2], h0[3]); w.z = cvt_pk_bf16(h1[0], h1[1]); w.w = cvt_pk_bf16(h1[2], h1[3]);
                *(u32x4*)rowp = w; }
    }
};
template <bool FINAL>
struct EpiResid16 {
    static constexpr bool PERM = true, AFTER_DRAIN = false;
    bf16_t* x16; float* ss; float* outf; int ldc; float scale;
    __device__ __forceinline__ void operator()(const f32x4 (&acc)[2][2][4][2], const Unit& u, int wr, int wc, int fr, int fq) const {
        const int row0 = u.pm * BM + wr * 64 + fr, col0 = u.pn * BM + wc * 32 + 8 * fq;
        u32x4 b[2][4][2];
#pragma unroll
        for (int ai = 0; ai < 2; ++ai)
#pragma unroll
            for (int m = 0; m < 4; ++m)
#pragma unroll
                for (int bj = 0; bj < 2; ++bj) b[ai][m][bj] = *(const u32x4*)(x16 + (size_t)(row0 + ai * HALF + m * 16) * ldc + col0 + bj * HALF);
        asm volatile("" ::: "memory");
#pragma unroll
        for (int ai = 0; ai < 2; ++ai)
#pragma unroll
            for (int m = 0; m < 4; ++m) { const int row = row0 + ai * HALF + m * 16; const size_t off = (size_t)row * ldc + col0; float part = 0.f;
#pragma unroll
                for (int bj = 0; bj < 2; ++bj) { const u32x4 w0 = b[ai][m][bj];
                    f32x4 v0 = {__uint_as_float(w0.x << 16), __uint_as_float(w0.x & 0xffff0000u), __uint_as_float(w0.y << 16), __uint_as_float(w0.y & 0xffff0000u)};
                    f32x4 v1 = {__uint_as_float(w0.z << 16), __uint_as_float(w0.z & 0xffff0000u), __uint_as_float(w0.w << 16), __uint_as_float(w0.w & 0xffff0000u)};
                    v0 = v0 + acc[ai][bj][m][0] * scale; v1 = v1 + acc[ai][bj][m][1] * scale;
                    if (FINAL) { *(f32x4*)(outf + off + bj * HALF) = v0; *(f32x4*)(outf + off + bj * HALF + 4) = v1; }
                    else { u32x4 w; w.x = cvt_pk_bf16(v0[0], v0[1]); w.y = cvt_pk_bf16(v0[2], v0[3]); w.z = cvt_pk_bf16(v1[0], v1[1]); w.w = cvt_pk_bf16(v1[2], v1[3]);
                        *(u32x4*)(x16 + off + bj * HALF) = w;
                        const float r0 = __uint_as_float(w.x << 16), r1 = __uint_as_float(w.x & 0xffff0000u), r2 = __uint_as_float(w.y << 16), r3 = __uint_as_float(w.y & 0xffff0000u);
                        const float r4 = __uint_as_float(w.z << 16), r5 = __uint_as_float(w.z & 0xffff0000u), r6 = __uint_as_float(w.w << 16), r7 = __uint_as_float(w.w & 0xffff0000u);
                        part += ((r0 * r0 + r1 * r1) + (r2 * r2 + r3 * r3)) + ((r4 * r4 + r5 * r5) + (r6 * r6 + r7 * r7)); } }
                if (!FINAL) { part += shx(part, 16); part += shx(part, 32);
                    if (fq == 0) ss[(size_t)row * 32 + u.pn * 4 + wc] = part; } }
    }
};

template <class Epi, class Sched, bool ALIGN_EPI = false, bool SP2 = false>
__device__ __forceinline__ void gemm_phase(PG8_LAS unsigned char* lds, const Gemm g, const Sched& S, const Epi& E, int tid_in) {
    int tid_ = tid_in; asm volatile("" : "+v"(tid_));
    const int tid = tid_, wid = __builtin_amdgcn_readfirstlane(tid >> 6), lane = tid & 63, wr = wid >> 2, wc = wid & 3, fr = lane & 15, fq = lane >> 4;
    const int K = g.K, nt = K / BK;
    unsigned voffA[2], voffB[2];
#pragma unroll
    for (int i = 0; i < 2; ++i) { int R, C; stage_rc(tid * 16 + i * 8192, R, C); const int Rb = Epi::PERM ? ((R & ~31) + perm32(R & 31)) : R;
        voffA[i] = (unsigned)(R * K + C) * 2u; voffB[i] = (unsigned)(Rb * K + C) * 2u; }
    const size_t kstep = (size_t)(BK * 2);
    const size_t hstep = (size_t)HALF * K * 2;
    const size_t tstep = 2 * hstep;
    const unsigned ldsw = (unsigned)wid * 1024u;
    const int aoff = lds_byte(wr * 64 + fr, fq * 8), boff = lds_byte(wc * 32 + fr, fq * 8);
#define PG8_SA(b, h) (((b) * 2 + (h)) * HTB)
#define PG8_SB(b, h) ((4 + (b) * 2 + (h)) * HTB)
#define PG8_STAGE(bufoff, gbase, voff) do { _Pragma("unroll") for (int _i = 0; _i < 2; ++_i) \
        __builtin_amdgcn_global_load_lds((const unsigned*)((const char*)(gbase) + (voff)[_i]), (PG8_LAS unsigned*)(lds + (bufoff) + ldsw + _i * 8192), 16, 0, 0); } while (0)
#define PG8_LDA(dst, b, h) do { _Pragma("unroll") for (int m = 0; m < 4; ++m) _Pragma("unroll") for (int k = 0; k < 2; ++k) dst[m][k] = *(const PG8_LAS bf16x8*)(lds + PG8_SA(b, h) + aoff + m * 2048 + k * 1024); } while (0)
#define PG8_LDB(dst, b, h) do { _Pragma("unroll") for (int n = 0; n < 2; ++n) _Pragma("unroll") for (int k = 0; k < 2; ++k) dst[n][k] = *(const PG8_LAS bf16x8*)(lds + PG8_SB(b, h) + boff + n * 2048 + k * 1024); } while (0)
#define PG8_PRIO(x) __builtin_amdgcn_s_setprio(x)
#define PG8_MMA(ai, bj, At, Bt) do { PG8_PRIO(1); _Pragma("unroll") for (int m = 0; m < 4; ++m) _Pragma("unroll") for (int n = 0; n < 2; ++n) _Pragma("unroll") for (int k = 0; k < 2; ++k) \
        acc[ai][bj][m][n] = __builtin_amdgcn_mfma_f32_16x16x32_bf16(Bt[n][k], At[m][k], acc[ai][bj][m][n], 0, 0, 0); PG8_PRIO(0); } while (0)
#define PG8_WAIT_V(n) asm volatile("s_waitcnt vmcnt(" #n ")" ::: "memory")
#define PG8_WAIT_L(n) asm volatile("s_waitcnt lgkmcnt(" #n ")" ::: "memory")
#define PG8_BAR __builtin_amdgcn_s_barrier()
#define PG8_SCHED __builtin_amdgcn_sched_barrier(0)
    Unit cur, nxt; int ui = 0;
    if (!S.next(0, cur)) return;
    f32x4 acc[2][2][4][2];
#pragma unroll
    for (int a = 0; a < 2; ++a)
#pragma unroll
        for (int b = 0; b < 2; ++b)
#pragma unroll
            for (int m = 0; m < 4; ++m)
#pragma unroll
                for (int n = 0; n < 2; ++n) acc[a][b][m][n] = (f32x4){0.f, 0.f, 0.f, 0.f};
    bf16x8 At[4][2], B0[2][2], B1[2][2];
    const char* cA = (const char*)g.A + (size_t)cur.pm * tstep; const char* cB = (const char*)g.Bt + (size_t)cur.pn * tstep;
    S.a_ready(cur);
    if constexpr (SP2) {
        PG8_STAGE(PG8_SB(0, 0), cB, voffB); PG8_STAGE(PG8_SB(0, 1), cB + hstep, voffB); PG8_STAGE(PG8_SA(0, 0), cA, voffA); PG8_STAGE(PG8_SA(0, 1), cA + hstep, voffA);
        if (wr == 1) PG8_BAR;
        PG8_WAIT_V(2); PG8_BAR;
        PG8_STAGE(PG8_SB(1, 0), cB + kstep, voffB); PG8_STAGE(PG8_SA(1, 0), cA + kstep, voffA); PG8_STAGE(PG8_SB(1, 1), cB + hstep + kstep, voffB);
        PG8_WAIT_V(6); PG8_BAR;
    } else {
        PG8_STAGE(PG8_SB(0, 0), cB, voffB); PG8_STAGE(PG8_SA(0, 0), cA, voffA); PG8_STAGE(PG8_SB(0, 1), cB + hstep, voffB); PG8_STAGE(PG8_SA(0, 1), cA + hstep, voffA);
        if (wr == 1) PG8_BAR;
        PG8_WAIT_V(4); PG8_BAR;
        PG8_STAGE(PG8_SB(1, 0), cB + kstep, voffB); PG8_STAGE(PG8_SA(1, 0), cA + kstep, voffA); PG8_STAGE(PG8_SB(1, 1), cB + hstep + kstep, voffB);
        PG8_WAIT_V(6); PG8_BAR;
    }
    for (;;) {
        const bool has_next = S.next(ui + 1, nxt);
        const char* nA = has_next ? (const char*)g.A + (size_t)nxt.pm * tstep : cA; const char* nB = has_next ? (const char*)g.Bt + (size_t)nxt.pn * tstep : cB;
        for (int t = 0; t < nt; t += 2) {
            const bool last = (t == nt - 2);
            const char* a1 = cA + (size_t)(t + 1) * kstep;
            const char* a2 = last ? nA : cA + (size_t)(t + 2) * kstep; const char* b2 = last ? nB : cB + (size_t)(t + 2) * kstep;
            const char* a3 = a2 + kstep; const char* b3 = b2 + kstep;
            if (last && has_next) S.a_ready(nxt);
            if constexpr (SP2) {
            PG8_LDB(B0, 0, 0); PG8_LDB(B1, 0, 1); PG8_SCHED; PG8_LDA(At, 0, 0); PG8_STAGE(PG8_SA(1, 1), a1 + hstep, voffA);
            PG8_WAIT_V(8); PG8_WAIT_L(0); PG8_BAR; PG8_MMA(0, 0, At, B0); PG8_MMA(0, 1, At, B1); PG8_BAR; PG8_SCHED;
            PG8_LDA(At, 0, 1); PG8_STAGE(PG8_SB(0, 0), b2, voffB); PG8_STAGE(PG8_SB(0, 1), b2 + hstep, voffB); PG8_STAGE(PG8_SA(0, 0), a2, voffA);
            PG8_WAIT_V(8); PG8_WAIT_L(0); PG8_BAR; PG8_MMA(1, 0, At, B0); PG8_MMA(1, 1, At, B1); PG8_BAR; PG8_SCHED;
            PG8_LDB(B0, 1, 0); PG8_LDB(B1, 1, 1); PG8_SCHED; PG8_LDA(At, 1, 0); PG8_STAGE(PG8_SA(0, 1), a2 + hstep, voffA);
            PG8_WAIT_V(8); PG8_WAIT_L(0); PG8_BAR; PG8_MMA(0, 0, At, B0); PG8_MMA(0, 1, At, B1); PG8_BAR; PG8_SCHED;
            PG8_LDA(At, 1, 1); PG8_STAGE(PG8_SB(1, 0), b3, voffB); PG8_STAGE(PG8_SB(1, 1), b3 + hstep, voffB); PG8_STAGE(PG8_SA(1, 0), a3, voffA);
            PG8_WAIT_V(8); PG8_WAIT_L(0); PG8_BAR; PG8_MMA(1, 0, At, B0); PG8_MMA(1, 1, At, B1); PG8_BAR; PG8_SCHED;
            } else {
            PG8_LDB(B0, 0, 0); PG8_SCHED; PG8_LDA(At, 0, 0); PG8_STAGE(PG8_SA(1, 1), a1 + hstep, voffA);
            PG8_WAIT_L(8); PG8_BAR; PG8_WAIT_L(0); PG8_MMA(0, 0, At, B0); PG8_BAR; PG8_SCHED;
            PG8_LDB(B1, 0, 1); PG8_STAGE(PG8_SB(0, 0), b2, voffB);
            PG8_BAR; PG8_WAIT_L(0); PG8_MMA(0, 1, At, B1); PG8_BAR;
            PG8_LDA(At, 0, 1); PG8_STAGE(PG8_SA(0, 0), a2, voffA);
            PG8_BAR; PG8_WAIT_L(0); PG8_MMA(1, 0, At, B0); PG8_BAR; PG8_SCHED;
            PG8_STAGE(PG8_SB(0, 1), b2 + hstep, voffB);
            PG8_WAIT_V(6); PG8_BAR; PG8_MMA(1, 1, At, B1); PG8_BAR;
            PG8_LDB(B0, 1, 0); PG8_SCHED; PG8_LDA(At, 1, 0); PG8_STAGE(PG8_SA(0, 1), a2 + hstep, voffA);
            PG8_WAIT_L(8); PG8_BAR; PG8_WAIT_L(0); PG8_MMA(0, 0, At, B0); PG8_BAR; PG8_SCHED;
            PG8_LDB(B1, 1, 1); PG8_STAGE(PG8_SB(1, 0), b3, voffB);
            PG8_BAR; PG8_WAIT_L(0); PG8_MMA(0, 1, At, B1); PG8_BAR;
            PG8_LDA(At, 1, 1); PG8_STAGE(PG8_SA(1, 0), a3, voffA);
            PG8_BAR; PG8_WAIT_L(0); PG8_MMA(1, 0, At, B0); PG8_BAR; PG8_SCHED;
            PG8_STAGE(PG8_SB(1, 1), b3 + hstep, voffB);
            PG8_WAIT_V(6); PG8_BAR; PG8_MMA(1, 1, At, B1); PG8_BAR;
            }
        }
        if constexpr (ALIGN_EPI) { if (wr == 0) PG8_BAR; }
        if constexpr (!Epi::AFTER_DRAIN) { E(acc, cur, wr, wc, fr, fq); S.done(cur); }
        if (!has_next) break;
#pragma unroll
        for (int a = 0; a < 2; ++a)
#pragma unroll
            for (int b = 0; b < 2; ++b)
#pragma unroll
                for (int m = 0; m < 4; ++m)
#pragma unroll
                    for (int n = 0; n < 2; ++n) { double z0_, z1_; asm volatile("v_mov_b64 %0, 0\n\tv_mov_b64 %1, 0" : "=v"(z0_), "=v"(z1_)); typedef double f64x2_ __attribute__((ext_vector_type(2))); acc[a][b][m][n] = __builtin_bit_cast(f32x4, (f64x2_){z0_, z1_}); }
        cur = nxt; cA = nA; cB = nB; ++ui;
        if constexpr (ALIGN_EPI) { if (wr == 1) PG8_BAR; }
    }
    PG8_WAIT_V(0);
    if constexpr (!ALIGN_EPI) { if (wr == 0) PG8_BAR; }
    PG8_BAR;
    if constexpr (Epi::AFTER_DRAIN) { E.fused(acc, cur, wr, wc, fr, fq, lds, wid, lane); S.done(cur); }
#undef PG8_SA
#undef PG8_SB
#undef PG8_STAGE
#undef PG8_LDA
#undef PG8_LDB
#undef PG8_MMA
#undef PG8_WAIT_V
#undef PG8_WAIT_L
#undef PG8_BAR
#undef PG8_SCHED
}
}

constexpr int NWAVES = 8;
constexpr int BATCH = 2, SEQ = 8192, DM = 2048, DFF = 5504, HD = 128;
constexpr int M = BATCH * SEQ;
constexpr int NQKV = 3 * DM, NKV = 2 * DM, NWI = 2 * DFF;
constexpr float EPS = 1e-6f;
constexpr float ATT_SCALE = 0.08838834764831845f;

constexpr size_t MiB = 1u << 20;
constexpr size_t WS_CTL = 0, CTL_ZERO_BYTES = 32 * 1024  ;
constexpr size_t SZ_WI = (size_t)NWI * DM * 2, SZ_WO = (size_t)DM * DFF * 2;
constexpr size_t WS_WI_PRE = 2 * MiB, WS_WI_POST = WS_WI_PRE + 4 * SZ_WI, WS_WO_PRE = WS_WI_POST + 4 * SZ_WI, WS_WO_POST = WS_WO_PRE + 4 * SZ_WO;
constexpr size_t WS_AWQKV = WS_WO_POST + 4 * SZ_WO, SZ_AWQKV = (size_t)NQKV * DM * 2;
constexpr size_t WS_AWO = WS_AWQKV + 2 * SZ_AWQKV, SZ_DD = (size_t)DM * DM * 2;
constexpr size_t WS_BWKV = WS_AWO + 2 * SZ_DD, WS_BWQ = WS_BWKV + 2 * SZ_DD, WS_BWO = WS_BWQ + 2 * SZ_DD;
constexpr size_t WS_LUT = WS_BWO + 2 * SZ_DD;
constexpr size_t WS_XN = WS_LUT + 1 * MiB, SZ_MD = (size_t)M * DM * 2;
constexpr size_t WS_OB = WS_XN + SZ_MD;
constexpr size_t WS_H = WS_OB + SZ_MD, SZ_H = (size_t)M * DFF * 2;
constexpr size_t WS_QKV = WS_H + SZ_H, SZ_QKV = (size_t)M * NQKV * 2;
constexpr size_t WS_KVSH = WS_QKV + SZ_QKV, SZ_KVSH = (size_t)M * NKV * 2;
constexpr size_t WS_SS = WS_KVSH + SZ_KVSH, SZ_SS = (size_t)M * 32 * 4;
constexpr size_t WS_END = WS_SS + 13 * SZ_SS;
constexpr int CW_TMO = 0, CW_CODE = 1;
constexpr int CW_BAR = 4096;
constexpr int RING_OFF = 0, RING_BYTES = 131072;
constexpr int LDSCTL_OFF = RING_BYTES, MISC_OFF = LDSCTL_OFF + 320;
constexpr int QKG_OFF = LDSCTL_OFF + 512, QKX_OFF = QKG_OFF + 1024;
constexpr int RSTD_OFF = QKX_OFF + 8192;
constexpr int LDS_BYTES = 155648;
static_assert(MISC_OFF + 128 <= QKG_OFF && RSTD_OFF + 11 * 1024 <= LDS_BYTES && LDS_BYTES <= 163840, "LDS map");

#define GAS __attribute__((address_space(1)))
#define LAS __attribute__((address_space(3)))
typedef unsigned short bf16;
typedef unsigned v4u __attribute__((ext_vector_type(4)));
typedef float f32x4 __attribute__((ext_vector_type(4)));
typedef short bf16x8 __attribute__((ext_vector_type(8)));
typedef GAS unsigned gu32;
typedef GAS unsigned long long gu64;
#define RLX_AGENT __ATOMIC_RELAXED, __HIP_MEMORY_SCOPE_AGENT
#define LDS_WAIT() asm volatile("s_waitcnt lgkmcnt(0)" ::: "memory")
#define VM_WAIT() asm volatile("s_waitcnt vmcnt(0)" ::: "memory")
__device__ __forceinline__ unsigned long long rt() { return __builtin_amdgcn_s_memrealtime(); }
__device__ __forceinline__ unsigned f2bf(float f) { unsigned u = __builtin_bit_cast(unsigned, f); return (u + 0x7fffu + ((u >> 16) & 1u)) >> 16; }
__device__ __forceinline__ unsigned pk2(float lo, float hi) { return f2bf(lo) | (f2bf(hi) << 16); }

#define XB_TMO      128
#define XB_XCNT(j)  (256  + 64 * (j))
#define XB_XSUB(j)  (1280 + 64 * (j))
#define XB_XGEN(j)  (2304 + 64 * (j))
#define XB_TOP      3328
#define XB_TOPGEN   3392
#define XCD_BAR_WORDS 3456
#define XB_SPIN_CAP (1u << 18)

__device__ __forceinline__ unsigned xb_ld(unsigned* p)              { return __hip_atomic_load(p, __ATOMIC_RELAXED, __HIP_MEMORY_SCOPE_AGENT); }
__device__ __forceinline__ unsigned xb_add(unsigned* p, unsigned v) { return __hip_atomic_fetch_add(p, v, __ATOMIC_RELAXED, __HIP_MEMORY_SCOPE_AGENT); }
__device__ __forceinline__ unsigned xb_xcc_id() { return (unsigned)__builtin_amdgcn_s_getreg((3 << 11) | 20) & 0xFu; }
#define XB_SPIN(cond, bar) do { unsigned _sp = 0; while (cond) { __builtin_amdgcn_s_sleep(1); \
    if ((++_sp & 255u) == 0u) { if (xb_ld(&(bar)[XB_TMO])) break; if (_sp > XB_SPIN_CAP) { atomicAdd(&(bar)[XB_TMO], 1u); break; } } } } while (0)

struct XcdBarrier {
    unsigned* bar; unsigned x; int tid;
    volatile LAS unsigned* st;
};

__device__ __forceinline__ XcdBarrier xcd_barrier_post(unsigned* bar, volatile LAS unsigned* st) {
    XcdBarrier b; b.bar = bar; b.x = xb_xcc_id(); b.st = st; b.tid = (int)threadIdx.x;
    if (threadIdx.x == 0) (void)xb_add(&bar[XB_XCNT(b.x)], 1u);
    return b;
}
__device__ __forceinline__ void xcd_barrier_complete(unsigned* bar, unsigned x, unsigned& nloc, unsigned& nx) {
    const unsigned G = gridDim.x * gridDim.y * gridDim.z;
    unsigned sum, cnt, mine, sp = 0u;
    for (;;) {
        sum = 0u; cnt = 0u; mine = 0u;
#pragma unroll
        for (unsigned j = 0; j < 16; ++j) { const unsigned c = xb_ld(&bar[XB_XCNT(j)]); sum += c; cnt += (c > 0u) ? 1u : 0u; mine = (j == x) ? c : mine; }
        if (sum == G) break;
        __builtin_amdgcn_s_sleep(1);
        if ((++sp & 255u) == 0u) { if (xb_ld(&bar[XB_TMO])) break; if (sp > XB_SPIN_CAP) { atomicAdd(&bar[XB_TMO], 1u); break; } }
    }
    nloc = mine > 0u ? mine : 1u; nx = cnt > 0u ? cnt : 1u;
}

__device__ __forceinline__ void xcd_barrier(const XcdBarrier& b) {
    asm volatile("s_waitcnt vmcnt(0)" ::: "memory");
    __syncthreads();
    int tid0_ = b.tid; asm volatile("" : "+v"(tid0_));
    if (tid0_ == 0) {
        unsigned* bar = b.bar;
        __builtin_amdgcn_s_waitcnt(0);
        unsigned nloc = b.st[0], nx = b.st[1];
        if (nloc == 0u) { xcd_barrier_complete(bar, b.x, nloc, nx); b.st[0] = nloc; b.st[1] = nx; }
        const unsigned old = xb_add(&bar[XB_XSUB(b.x)], 1u);
        const unsigned gen = old / nloc;
        if (old + 1u == (gen + 1u) * nloc) {
            __builtin_amdgcn_fence(__ATOMIC_RELEASE, "agent");
            asm volatile("s_waitcnt vmcnt(0)" ::: "memory");
            const unsigned og = xb_add(&bar[XB_TOP], 1u);
            const unsigned tg = og / nx;
            if (og + 1u == (tg + 1u) * nx) xb_add(&bar[XB_TOPGEN], 1u);
            else XB_SPIN(xb_ld(&bar[XB_TOPGEN]) == tg, bar);
            __builtin_amdgcn_fence(__ATOMIC_ACQUIRE, "agent");
            xb_add(&bar[XB_XGEN(b.x)], 1u);
            asm volatile("s_waitcnt vmcnt(0)" ::: "memory");
        } else {
            XB_SPIN(xb_ld(&bar[XB_XGEN(b.x)]) == gen, bar);
            __builtin_amdgcn_fence(__ATOMIC_ACQUIRE, "agent");
            asm volatile("s_waitcnt vmcnt(0)" ::: "memory");
        }
    }
    __syncthreads();
}

struct Args { const float* in[19]; float* out; unsigned char* ws; };
__device__ __forceinline__ int launder_v(int v) { asm volatile("" : "+v"(v)); return v; }
#define CUR_TID(F) (((F).wave << 6) | lane_id())
struct Frame {
    LAS unsigned char* lds;
    volatile LAS unsigned* MISC;
    gu32* ctl;
    int wave;
    int vcu, G;
};
__device__ __forceinline__ float wave_sum(float v) {
#pragma unroll
    for (int o = 1; o < 64; o <<= 1) v += shx(v, o);
    return v;
}
__device__ __forceinline__ float wave_max(float v) {
#pragma unroll
    for (int o = 1; o < 64; o <<= 1) v = fmaxf(v, shx(v, o));
    return v;
}
__device__ __forceinline__ float bf2f(unsigned short h) { return __uint_as_float((unsigned)h << 16); }
__device__ __forceinline__ float bflo(unsigned w) { return __uint_as_float(w << 16); }
__device__ __forceinline__ float bfhi(unsigned w) { return __uint_as_float(w & 0xffff0000u); }

__device__ __forceinline__ int t5_bucket(int n) {
    if (n < 16) return n;
    if (n >= 113) return 31;
    int b = 16;
    b += (n >= 19); b += (n >= 21); b += (n >= 24); b += (n >= 27); b += (n >= 31); b += (n >= 35); b += (n >= 40); b += (n >= 46);
    b += (n >= 52); b += (n >= 59); b += (n >= 67); b += (n >= 77); b += (n >= 87); b += (n >= 99);
    return b;
}

template <bool GLU>
__device__ __forceinline__ void transpose_group(Frame& F, int part, int nparts, const float* W, const float* gain, int L, int K, int N, bf16* WT, LAS float* scr, float wscale = 1.0f) {
    int gw = part * NWAVES + F.wave; asm volatile("" : "+s"(gw)); const int NGW = nparts * NWAVES; const int lane = lane_id();
    const int nblk = N / 32, kblk = K / 64, per = nblk * kblk, total = L * per;
    const int c = lane & 7, lr = lane >> 3;
    f32x4 v[8], g0 = {1.f, 1.f, 1.f, 1.f}, g1 = g0;
#define TG_DECODE(it_) const int l_ = (it_) / per, r_ = (it_) - l_ * per, kb_ = r_ / nblk, nb_ = r_ - kb_ * nblk, n0_ = nb_ * 32, k0_ = kb_ * 64; const size_t lo_ = (size_t)l_ * K * N;
#define TG_LOAD(it_) do { TG_DECODE(it_); const float* w_ = W + lo_ + (size_t)(k0_ + lr) * N + n0_ + 4 * c;                                                   \
        _Pragma("unroll") for (int i = 0; i < 8; ++i) v[i] = *(const GAS f32x4*)(w_ + (size_t)(8 * i) * N);                                                    \
        if (gain) { const float* g_ = gain + (size_t)l_ * K + k0_ + 8 * c; g0 = *(const GAS f32x4*)g_; g1 = *(const GAS f32x4*)(g_ + 4); } } while (0)
    if (gw < total) TG_LOAD(gw);
    for (int it = gw; it < total; it += NGW) {
#pragma unroll
        for (int i = 0; i < 8; ++i) { LAS float* d = scr + (8 * i + lr) * 33 + 4 * c; d[0] = v[i].x; d[1] = v[i].y; d[2] = v[i].z; d[3] = v[i].w; }
        const f32x4 h0 = g0 * wscale, h1 = g1 * wscale;
        LDS_WAIT(); asm volatile("" ::: "memory");
        if (it + NGW < total) TG_LOAD(it + NGW);
        TG_DECODE(it);
        int drow0 = n0_;
        if (GLU) { const int half = N / 2; const int cc = n0_ >= half ? n0_ - half : n0_; drow0 = (cc >> 7) * 256 + (n0_ >= half ? 128 : 0) + (cc & 127); }
        bf16* wt_ = WT + lo_ + (size_t)drow0 * K + k0_ + 8 * c;
#pragma unroll
        for (int j = 0; j < 4; ++j) { const int n = lr + 8 * j; const LAS float* s = scr + (8 * c) * 33 + n;
            v4u o; o.x = pg8::cvt_pk_bf16(s[0 * 33] * h0.x, s[1 * 33] * h0.y); o.y = pg8::cvt_pk_bf16(s[2 * 33] * h0.z, s[3 * 33] * h0.w); o.z = pg8::cvt_pk_bf16(s[4 * 33] * h1.x, s[5 * 33] * h1.y); o.w = pg8::cvt_pk_bf16(s[6 * 33] * h1.z, s[7 * 33] * h1.w);
            *(GAS v4u*)(wt_ + (size_t)n * K) = o; }
        LDS_WAIT(); asm volatile("" ::: "memory");
    }
#undef TG_LOAD
#undef TG_DECODE
}
__device__ __forceinline__ void cast_rows(Frame& F, const float* x, bf16* xb, float* ss) {
    int gw = F.vcu * NWAVES + F.wave; asm volatile("" : "+s"(gw)); const int NGW = F.G * NWAVES; const int lane = lane_id();
    for (int m = gw; m < M; m += NGW) {
        const GAS f32x4* xr = (const GAS f32x4*)(x + (size_t)m * DM) + lane;
        f32x4 v[8]; float s = 0.f;
#pragma unroll
        for (int j = 0; j < 8; ++j) { v[j] = xr[64 * j]; s += (v[j].x * v[j].x + v[j].y * v[j].y) + (v[j].z * v[j].z + v[j].w * v[j].w); }
        s = wave_sum(s);
        GAS unsigned long long* o8 = (GAS unsigned long long*)(xb + (size_t)m * DM) + lane;
#pragma unroll
        for (int j = 0; j < 8; ++j) o8[64 * j] = (unsigned long long)pk2(v[j].x, v[j].y) | ((unsigned long long)pk2(v[j].z, v[j].w) << 32);
        if (lane < 32) ss[(size_t)m * 32 + lane] = lane == 0 ? s : 0.f;
    }
}
namespace att {
typedef short s16x4 __attribute__((ext_vector_type(4)));
typedef float f32x16 __attribute__((ext_vector_type(16)));
typedef unsigned u32x4 __attribute__((ext_vector_type(4)));
constexpr int NW = 8, QBLK = 32, KVBLK = 64, QB = NW * QBLK, D = 128;
constexpr int SHM_V = KVBLK * D * 2, SHM_K = KVBLK * D * 2;
constexpr int LDS_WS = 2 * SHM_V + 2 * SHM_K;
constexpr float SCALE = 0.08838834764831845f;
#define KSWZ(row, colB) ((row) * 256 + ((colB) ^ (((row) & 7) << 4)))
#define SBAR() __builtin_amdgcn_sched_barrier(0)
__device__ __forceinline__ int v_st(int k, int c) { const int kk = (k & ~0xC) | ((k & 4) << 1) | ((k & 8) >> 1); return ((kk >> 3) * 4 + (c >> 5)) * 512 + ((kk & 7) * 32 + (c & 31)) * 2; }
__device__ __forceinline__ int v_rd_base(int lane) { return ((lane & 3) << 3) | (((lane >> 2) & 3) << 6) | (((lane >> 4) & 1) << 5) | (((lane >> 5) & 1) << 8); }
constexpr int v_rd_off(int d0, int ks, int half) { return d0 * 512 + ks * 4096 + half * 2048; }
__device__ __forceinline__ int crow(int r, int hi) { return (r & 3) + 8 * (r >> 2) + 4 * hi; }
__device__ __forceinline__ unsigned cvtpk(float lo, float hi) { unsigned r; asm volatile("v_cvt_pk_bf16_f32 %0, %1, %2" : "=v"(r) : "v"(lo), "v"(hi)); return r; }
__device__ __forceinline__ bf16x8 load8(const bf16* p) { return *reinterpret_cast<const bf16x8*>(p); }

#define PK4(P, B_, OUT) do { unsigned a0 = cvtpk(P[B_+0], P[B_+1]), a1 = cvtpk(P[B_+2], P[B_+3]);                          \
        unsigned b0 = cvtpk(P[B_+4], P[B_+5]), b1 = cvtpk(P[B_+6], P[B_+7]);                                             \
        auto r0 = __builtin_amdgcn_permlane32_swap(a0, b0, false, false); auto r1 = __builtin_amdgcn_permlane32_swap(a1, b1, false, false); \
        u32x4 w = {r0[0], r1[0], r0[1], r1[1]}; OUT = *reinterpret_cast<bf16x8*>(&w); } while (0)
template <int KB>
__device__ __forceinline__ void qkt(f32x16& p0, f32x16& p1, const char* K_lds, int r32, int hi, const bf16x8* qr) {
    p0 = f32x16{}; p1 = f32x16{};
    const char* kb[4];
#pragma unroll
    for (int dd = 0; dd < 4; ++dd) kb[dd] = K_lds + KB * SHM_K + KSWZ(r32, (dd * 16 + hi * 8) * 2);
#pragma unroll
    for (int d0 = 0; d0 < 8; ++d0) { const char* a = kb[d0 & 3] + (d0 >> 2) * 128;
        bf16x8 b0 = *reinterpret_cast<const bf16x8*>(a);
        bf16x8 b1 = *reinterpret_cast<const bf16x8*>(a + 32 * 256);
        p0 = __builtin_amdgcn_mfma_f32_32x32x16_bf16(b0, qr[d0], p0, 0, 0, 0);
        p1 = __builtin_amdgcn_mfma_f32_32x32x16_bf16(b1, qr[d0], p1, 0, 0, 0); }
}
template <int VB>
__device__ __forceinline__ void pv_tile(f32x16* o, int vb0, bf16x8 pa0, bf16x8 pa1, bf16x8 pa2, bf16x8 pa3) {
#define TRRD(dst, off) asm volatile("ds_read_b64_tr_b16 %0, %1 offset:%2" : "=&v"(dst) : "v"(vb0), "i"(off) : "memory")
#define PV_D0(d0) do { s16x4 l0, l1, l2, l3, h0, h1, h2, h3; constexpr int b_ = VB * SHM_V + v_rd_off(d0, 0, 0);   \
        TRRD(l0, b_); TRRD(h0, b_ + 2048); TRRD(l1, b_ + 4096); TRRD(h1, b_ + 6144); TRRD(l2, b_ + 8192); TRRD(h2, b_ + 10240); TRRD(l3, b_ + 12288); TRRD(h3, b_ + 14336); \
        asm volatile("s_waitcnt lgkmcnt(0)" ::: "memory"); SBAR();   \
        o[d0] = __builtin_amdgcn_mfma_f32_32x32x16_bf16(pa0, (bf16x8){l0[0], l0[1], l0[2], l0[3], h0[0], h0[1], h0[2], h0[3]}, o[d0], 0, 0, 0);   \
        o[d0] = __builtin_amdgcn_mfma_f32_32x32x16_bf16(pa1, (bf16x8){l1[0], l1[1], l1[2], l1[3], h1[0], h1[1], h1[2], h1[3]}, o[d0], 0, 0, 0);   \
        o[d0] = __builtin_amdgcn_mfma_f32_32x32x16_bf16(pa2, (bf16x8){l2[0], l2[1], l2[2], l2[3], h2[0], h2[1], h2[2], h2[3]}, o[d0], 0, 0, 0);   \
        o[d0] = __builtin_amdgcn_mfma_f32_32x32x16_bf16(pa3, (bf16x8){l3[0], l3[1], l3[2], l3[3], h3[0], h3[1], h3[2], h3[3]}, o[d0], 0, 0, 0); } while (0)
    PV_D0(0); PV_D0(1); PV_D0(2); PV_D0(3);
#undef PV_D0
#undef TRRD
}

struct BlockRef { const bf16* Q; const bf16* K; const bf16* V; bf16* O; int P0; };
struct Seam { bf16x8 qr[8]; bf16x8 st_v0, st_v1, st_k0, st_k1; };
#define LD16(base, boff) (*(const bf16x8*)((const char*)(base) + (size_t)(boff) + loff))
#define VMW() asm volatile("s_waitcnt vmcnt(0)" ::: "memory")
#define SLOAD_H(Kp, Vp, k0) do { const size_t ko_ = (size_t)(k0) * KS * 2; S.st_v0 = LD16(Vp, ko_); S.st_v1 = LD16(Vp, ko_ + 32 * VS * 2);              \
                         S.st_k0 = LD16(Kp, ko_); S.st_k1 = LD16(Kp, ko_ + 32 * KS * 2); } while (0)
#define SWRITE_HK(bf) do { *(bf16x8*)(K_lds + (bf) * SHM_K + kws) = S.st_k0; *(bf16x8*)(K_lds + (bf) * SHM_K + kws + 32 * 256) = S.st_k1; } while (0)
#define SWRITE_HV(bf) do { *(bf16x8*)(V_lds + (bf) * SHM_V + vst0) = S.st_v0; *(bf16x8*)(V_lds + (bf) * SHM_V + vst1) = S.st_v1; } while (0)
#define SWRITE_H(bf) do { SWRITE_HV(bf); SWRITE_HK(bf); } while (0)

__device__ __forceinline__ void sb_weights(f32x16& p0, f32x16& p1, int dq, bool need_mask, int hi, float& C, bf16x8& pa0, bf16x8& pa1, bf16x8& pa2, bf16x8& pa3) {
    float qs[8], osi[9];
#pragma unroll
    for (int g = 0; g < 8; ++g) {
        float lk[4], y[4];
#pragma unroll
        for (int i = 0; i < 4; ++i) {
            y[i] = g < 4 ? p0[4 * g + i] : p1[4 * (g - 4) + i];
            const float sp = fmaxf(y[i], 0.f) + __builtin_amdgcn_logf(1.0f + __builtin_amdgcn_exp2f(-fabsf(y[i])));
            const int c = i + 8 * g;
            const bool valid = !need_mask || (dq - c > 0);
            lk[i] = valid ? -sp : 0.f;
            y[i] = valid ? y[i] : -__builtin_inff();
        }
        const float s2 = lk[3], s1 = s2 + lk[2], s0 = s1 + lk[1];
        qs[g] = s0 + lk[0];
        const float e0 = y[0] + lk[0] + s0, e1 = y[1] + lk[1] + s1, e2 = y[2] + lk[2] + s2, e3 = y[3] + lk[3];
        if (g < 4) { p0[4 * g] = e0; p0[4 * g + 1] = e1; p0[4 * g + 2] = e2; p0[4 * g + 3] = e3; }
        else { p1[4 * (g - 4)] = e0; p1[4 * (g - 4) + 1] = e1; p1[4 * (g - 4) + 2] = e2; p1[4 * (g - 4) + 3] = e3; }
    }
    osi[8] = 0.f;
#pragma unroll
    for (int g = 7; g >= 0; --g) osi[g] = qs[g] + osi[g + 1];
    float tot;
    { auto rr = __builtin_amdgcn_permlane32_swap(__float_as_uint(osi[0]), __float_as_uint(osi[0]), false, false); tot = __uint_as_float(rr[0]) + __uint_as_float(rr[1]); }
#pragma unroll
    for (int g = 0; g < 8; ++g) {
        auto rr = __builtin_amdgcn_permlane32_swap(__float_as_uint(osi[g]), __float_as_uint(osi[g + 1]), false, false);
        const float T = osi[g + 1] + (hi ? __uint_as_float(rr[0]) : __uint_as_float(rr[1])) + C;
#pragma unroll
        for (int i = 0; i < 4; ++i) {
            if (g < 4) p0[4 * g + i] = __builtin_amdgcn_exp2f(p0[4 * g + i] + T); else p1[4 * (g - 4) + i] = __builtin_amdgcn_exp2f(p1[4 * (g - 4) + i] + T);
        }
    }
    C += tot;
    PK4(p0, 0, pa0); PK4(p0, 8, pa1); PK4(p1, 0, pa2); PK4(p1, 8, pa3);
}
template <int QS, int KS, int VS, int OS, bool EXIT>
__device__ __forceinline__ void sb_block(const BlockRef& cur, char* lds, int tid) {
    static_assert(KS == VS, "one lane offset serves K and V");
    const int wid = __builtin_amdgcn_readfirstlane(tid >> 6), lane = tid & 63, r32 = lane & 31, hi = lane >> 5;
    const int NT = cur.P0 / KVBLK + 4;
    const int qlo = cur.P0 + wid * QBLK, qm = qlo + r32 - 4 * hi;
    char* V_lds = lds; char* K_lds = lds + 2 * SHM_V;
    volatile LAS unsigned* flags = (volatile LAS unsigned*)(uintptr_t)((unsigned)(uintptr_t)lds + LDS_WS);
    const int sr = tid >> 4, sc = (tid & 15) * 8, vst0 = v_st(sr, sc), vst1 = v_st(32 + sr, sc), kws = KSWZ(sr, sc * 2);
    const unsigned loff = (unsigned)(sr * KS + sc) * 2u, qoff = (unsigned)(r32 * QS + hi * 8) * 2u;
    const int vb0 = (int)(uintptr_t)V_lds + v_rd_base(lane);
    Seam S;
#pragma unroll
    for (int d0 = 0; d0 < 8; ++d0) S.qr[d0] = *(const bf16x8*)((const char*)cur.Q + (size_t)(wid * QBLK) * QS * 2 + d0 * 32 + qoff);
#define KBASE(t) ((NT - 1 - (t)) * KVBLK)
    SLOAD_H(cur.K, cur.V, KBASE(0)); VMW(); SWRITE_H(0);
    SLOAD_H(cur.K, cur.V, KBASE(1));
    __syncthreads();
    f32x16 o[4] = {}; float C = 0.f; f32x16 p0, p1; bf16x8 pa0, pa1, pa2, pa3;
    bool wdone = false;
#define SB_STEP(t, B) do {                                                                                       \
        { const int kb_ = KBASE(t);                                                                               \
          if (!wdone && kb_ < qlo + QBLK) {                  \
            SBAR(); qkt<B>(p0, p1, K_lds, r32, hi, S.qr);                                                          \
            sb_weights(p0, p1, qm - kb_, kb_ + KVBLK > qlo, hi, C, pa0, pa1, pa2, pa3);                            \
            SBAR(); pv_tile<B>(o, vb0, pa0, pa1, pa2, pa3);                                                        \
            if (EXIT) wdone = __all(C < -160.f); } }                                                              \
        if (EXIT) { if (lane == 0) flags[((t) & 1) * 8 + wid] = wdone ? 1u : 0u; }                                 \
        if ((t) + 1 < NT) { VMW(); SWRITE_H((B) ^ 1); if ((t) + 2 < NT) SLOAD_H(cur.K, cur.V, KBASE((t) + 2)); }  \
        __syncthreads(); } while (0)
    for (int t = 0; t < NT; t += 2) {
        SB_STEP(t, 0);
        SB_STEP(t + 1, 1);
        if (EXIT) { unsigned a = 1u;
#pragma unroll
            for (int w = 0; w < 8; ++w) a &= flags[8 + w];
            if (a) break; }
    }
    VMW();
    char* Ow = (char*)cur.O + (size_t)(wid * QBLK) * OS * 2; const unsigned ooff = (unsigned)(4 * hi * OS + r32) * 2u;
#pragma unroll
    for (int r = 0; r < 16; ++r) { const int orow0 = (r & 3) + 8 * (r >> 2);
#pragma unroll
        for (int d0 = 0; d0 < 4; ++d0) { const float v = o[d0][r];
            const float vn = shx(v, 1);
            if ((r32 & 1) == 0) *(unsigned*)(Ow + (size_t)(orow0 * OS + d0 * 32) * 2 + ooff) = cvtpk(v, vn); } }
    __syncthreads();
#undef KBASE
#undef SB_STEP
}
}
namespace att2 {
using att::f32x16; using att::s16x4; using att::u32x4; using att::cvtpk; using att::crow;
constexpr int STG = 32768, K2_OFF = 8192, V_OFF = 16384;
constexpr int LDS_WS = 131072 + 512, LDS_LUT = LDS_WS + 2048, LDS_END = LDS_LUT + 2 * 272 * 4;
constexpr float SCALE = att::SCALE, C2 = 1.4426950408889634f * SCALE;
#define SBAR() __builtin_amdgcn_sched_barrier(0)
#define A2_WAITV(n) asm volatile("s_waitcnt vmcnt(" #n ")" ::: "memory")
#define A2_BAR() do { asm volatile("s_waitcnt lgkmcnt(0)" ::: "memory"); __builtin_amdgcn_s_barrier(); asm volatile("" ::: "memory"); } while (0)
__device__ __forceinline__ void bias_mask16(f32x16& p, int dq, const LAS float* lut) {
    const float NEG = -__builtin_inff();
    const LAS float* lp = lut + 64 + dq;
    float bv[16];
#pragma unroll
    for (int r = 0; r < 16; ++r) { const int c = (r & 3) + 8 * (r >> 2); bv[r] = lp[-c]; }
#pragma unroll
    for (int r = 0; r < 16; ++r) { const int c = (r & 3) + 8 * (r >> 2); p[r] = (dq - c >= 0) ? p[r] + bv[r] : NEG; }
}
__device__ __forceinline__ void partialSM16(f32x16& p, float& m_reg, float& alpha, float bo) {
    constexpr float THR = 8.f;
    float pmax = p[0];
#pragma unroll
    for (int r = 1; r < 16; ++r) pmax = fmaxf(pmax, p[r]);
    { auto rr = __builtin_amdgcn_permlane32_swap(__float_as_uint(pmax), __float_as_uint(pmax), false, false); pmax = fmaxf(__uint_as_float(rr[0]), __uint_as_float(rr[1])); }
    pmax += bo;
    float mn;
    if (__builtin_expect(__all((pmax - m_reg) * SCALE <= THR), 1)) { mn = m_reg; alpha = 1.f; }
    else { mn = fmaxf(m_reg, pmax); alpha = __builtin_amdgcn_exp2f((m_reg - mn) * C2); m_reg = mn; }
    const float mnL = (bo - mn) * C2;
#pragma unroll
    for (int r = 0; r < 16; ++r) p[r] = fmaf(p[r], C2, mnL);
}
__device__ __forceinline__ void finishSM16(f32x16& p, float alpha, float& l_reg, bf16x8& pa0, bf16x8& pa1) {
#pragma unroll
    for (int r = 0; r < 16; ++r) p[r] = __builtin_amdgcn_exp2f(p[r]);
    float ps = 0.f;
#pragma unroll
    for (int r = 0; r < 16; ++r) ps += p[r];
    { auto rr = __builtin_amdgcn_permlane32_swap(__float_as_uint(ps), __float_as_uint(ps), false, false); ps = __uint_as_float(rr[0]) + __uint_as_float(rr[1]); }
    l_reg = l_reg * alpha + ps;
    PK4(p, 0, pa0); PK4(p, 8, pa1);
}
#define KRD(dst, addr, off) asm volatile("ds_read_b128 %0, %1 offset:%2" : "=&v"(dst) : "v"(addr), "i"(off) : "memory")
#define KWAIT(n, dst) asm volatile("s_waitcnt lgkmcnt(" #n ")" : "+v"(dst) :: "memory")
__device__ __forceinline__ void qkt16_exp(f32x16& px, f32x16& py, int kb, const int (&kofs)[4], const bf16x8* qr) {
    bf16x8 k0, k1;
    KRD(k0, kb + kofs[0], 0); KRD(k1, kb + kofs[1], 0);
    px = f32x16{};
#define EX2(i) do { py[2 * (i)] = __builtin_amdgcn_exp2f(py[2 * (i)]); py[2 * (i) + 1] = __builtin_amdgcn_exp2f(py[2 * (i) + 1]); } while (0)
    KWAIT(1, k0); px = __builtin_amdgcn_mfma_f32_32x32x16_bf16(k0, qr[0], px, 0, 0, 0); KRD(k0, kb + kofs[2], 0);   EX2(0); SBAR();
    KWAIT(1, k1); px = __builtin_amdgcn_mfma_f32_32x32x16_bf16(k1, qr[1], px, 0, 0, 0); KRD(k1, kb + kofs[3], 0);   EX2(1); SBAR();
    KWAIT(1, k0); px = __builtin_amdgcn_mfma_f32_32x32x16_bf16(k0, qr[2], px, 0, 0, 0); KRD(k0, kb + kofs[0], 128); EX2(2); SBAR();
    KWAIT(1, k1); px = __builtin_amdgcn_mfma_f32_32x32x16_bf16(k1, qr[3], px, 0, 0, 0); KRD(k1, kb + kofs[1], 128); EX2(3); SBAR();
    KWAIT(1, k0); px = __builtin_amdgcn_mfma_f32_32x32x16_bf16(k0, qr[4], px, 0, 0, 0); KRD(k0, kb + kofs[2], 128); EX2(4); SBAR();
    KWAIT(1, k1); px = __builtin_amdgcn_mfma_f32_32x32x16_bf16(k1, qr[5], px, 0, 0, 0); KRD(k1, kb + kofs[3], 128); EX2(5); SBAR();
    KWAIT(1, k0); px = __builtin_amdgcn_mfma_f32_32x32x16_bf16(k0, qr[6], px, 0, 0, 0); EX2(6); SBAR();
    KWAIT(0, k1); px = __builtin_amdgcn_mfma_f32_32x32x16_bf16(k1, qr[7], px, 0, 0, 0); EX2(7); SBAR();
#undef EX2
}
__device__ __forceinline__ void finish_pack16(f32x16& p, float alpha, float& l_reg, bf16x8& pa0, bf16x8& pa1) {
    float ps = 0.f;
#pragma unroll
    for (int r = 0; r < 16; ++r) ps += p[r];
    { auto rr = __builtin_amdgcn_permlane32_swap(__float_as_uint(ps), __float_as_uint(ps), false, false); ps = __uint_as_float(rr[0]) + __uint_as_float(rr[1]); }
    l_reg = l_reg * alpha + ps;
    PK4(p, 0, pa0); PK4(p, 8, pa1);
}
__device__ __forceinline__ void qkt16(f32x16& p, const char* sb, const int (&kofs)[4], const bf16x8* qr) {
    p = f32x16{};
#pragma unroll
    for (int d0 = 0; d0 < 8; ++d0) { const bf16x8 kf = *reinterpret_cast<const bf16x8*>(sb + kofs[d0 & 3] + (d0 >> 2) * 128);
        p = __builtin_amdgcn_mfma_f32_32x32x16_bf16(kf, qr[d0], p, 0, 0, 0); }
}
__device__ __forceinline__ void pv16(f32x16* o, int vb, bf16x8 pa0, bf16x8 pa1) {
#define TRRD(dst, off) asm volatile("ds_read_b64_tr_b16 %0, %1 offset:%2" : "=&v"(dst) : "v"(vb), "i"(off) : "memory")
#define RD4(S, d0) do { TRRD(S##l0, (d0) * 512); TRRD(S##h0, (d0) * 512 + 4096); TRRD(S##l1, (d0) * 512 + 8192); TRRD(S##h1, (d0) * 512 + 12288); } while (0)
#define MM2(S, d0) do { o[d0] = __builtin_amdgcn_mfma_f32_32x32x16_bf16(pa0, (bf16x8){S##l0[0], S##l0[1], S##l0[2], S##l0[3], S##h0[0], S##h0[1], S##h0[2], S##h0[3]}, o[d0], 0, 0, 0);   \
        o[d0] = __builtin_amdgcn_mfma_f32_32x32x16_bf16(pa1, (bf16x8){S##l1[0], S##l1[1], S##l1[2], S##l1[3], S##h1[0], S##h1[1], S##h1[2], S##h1[3]}, o[d0], 0, 0, 0); } while (0)
#define WAITL(n) asm volatile("s_waitcnt lgkmcnt(" #n ")" ::: "memory")
    s16x4 Al0, Ah0, Al1, Ah1, Bl0, Bh0, Bl1, Bh1;
    RD4(A, 0);
    RD4(B, 1); WAITL(4); SBAR(); MM2(A, 0); SBAR();
    RD4(A, 2); WAITL(4); SBAR(); MM2(B, 1); SBAR();
    RD4(B, 3); WAITL(4); SBAR(); MM2(A, 2); SBAR();
    RD4(A, 4); WAITL(4); SBAR(); MM2(B, 3); SBAR();
    RD4(B, 5); WAITL(4); SBAR(); MM2(A, 4); SBAR();
    RD4(A, 6); WAITL(4); SBAR(); MM2(B, 5); SBAR();
    RD4(B, 7); WAITL(4); SBAR(); MM2(A, 6); SBAR();
    WAITL(0); SBAR(); MM2(B, 7);
#undef RD4
#undef MM2
#undef WAITL
#undef TRRD
}
template <int LD, int OLD>
__device__ __forceinline__ void diff_unit(const bf16* QKVb, bf16* Ob, int h, int P0, LAS unsigned char* ldsl, int tid, float lam, float oml, const float* subln, float bfar) {
    char* lds = (char*)ldsl;
    asm volatile("" : "+v"(tid));
    const int wid = __builtin_amdgcn_readfirstlane(tid >> 6), lane = tid & 63, r32 = lane & 31, hi = lane >> 5, rg = wid & 3, mp = wid >> 2;
    const int qlo = P0 + 32 * rg, qm = qlo + r32 - 4 * hi;
    const int NS = P0 / 32 + 4;
    float* wsf = (float*)(lds + LDS_WS) + wid * 64; float* li_l = wsf, * al_l = wsf + 32;
    const LAS float* lut = (const LAS float*)(ldsl + LDS_LUT) + mp * 272;
    bf16x8 qr[8];
    { const char* qb = (const char*)(QKVb + (size_t)qlo * LD + (2 * h + mp) * 128); const unsigned qoff = (unsigned)(r32 * LD + hi * 8) * 2u;
#pragma unroll
      for (int d0 = 0; d0 < 8; ++d0) qr[d0] = *(const bf16x8*)(qb + d0 * 32 + qoff); }
    unsigned koff, voff;
    { const int r = 4 * wid + (lane >> 4), c = (lane & 15) ^ (r & 7); koff = (unsigned)(r * LD + c * 8) * 2u;
      const int s = 2 * wid + (lane >> 5), kg = s >> 3, cb = s & 7, rr = (lane >> 2) & 7, q = lane & 3, kk = kg * 8 + rr, k = (kk & ~0xC) | ((kk & 4) << 1) | ((kk & 8) >> 1);
      voff = (unsigned)(k * LD + cb * 32 + q * 8) * 2u; }
    const char* Kg = (const char*)(QKVb + 2048 + (2 * h) * 128); const char* Vg = (const char*)(QKVb + 4096 + h * 256);
#define A2_DMA(u) do { if (mp == 0) { const size_t ro_ = (size_t)(u) * 32 * LD * 2; LAS unsigned char* sb_ = ldsl + ((u) & 3) * STG + wid * 1024;                  \
        __builtin_amdgcn_global_load_lds((const unsigned*)(Kg + ro_ + koff), (LAS unsigned*)(sb_), 16, 0, 0);                                                           \
        __builtin_amdgcn_global_load_lds((const unsigned*)(Kg + ro_ + 256 + koff), (LAS unsigned*)(sb_ + K2_OFF), 16, 0, 0);                                            \
        __builtin_amdgcn_global_load_lds((const unsigned*)(Vg + ro_ + voff), (LAS unsigned*)(sb_ + V_OFF), 16, 0, 0);                                                   \
        __builtin_amdgcn_global_load_lds((const unsigned*)(Vg + ro_ + (size_t)16 * LD * 2 + voff), (LAS unsigned*)(sb_ + V_OFF + 8192), 16, 0, 0);                       \
                      \
        __builtin_amdgcn_global_load_lds((const unsigned*)(Kg + ro_ + (size_t)16 * LD * 2 + koff), (LAS unsigned*)(sb_ + 4096), 16, 0, 0);                               \
        __builtin_amdgcn_global_load_lds((const unsigned*)(Kg + ro_ + (size_t)16 * LD * 2 + 256 + koff), (LAS unsigned*)(sb_ + 4096 + K2_OFF), 16, 0, 0);                \
        __builtin_amdgcn_global_load_lds((const unsigned*)(Vg + ro_ + (size_t)4 * LD * 2 + voff), (LAS unsigned*)(sb_ + 4096 + V_OFF), 16, 0, 0);                        \
        __builtin_amdgcn_global_load_lds((const unsigned*)(Vg + ro_ + (size_t)20 * LD * 2 + voff), (LAS unsigned*)(sb_ + 4096 + V_OFF + 8192), 16, 0, 0); } } while (0)
    int kofs[4];
#pragma unroll
    for (int dd = 0; dd < 4; ++dd) kofs[dd] = mp * K2_OFF + KSWZ(r32, (dd * 16 + hi * 8) * 2);
    const int vb0 = (int)(uintptr_t)lds + V_OFF + att::v_rd_base(lane);
    float m_reg = -1e30f, l_reg = 0.f; f32x16 o[8] = {};
    f32x16 pA, pB; float alA, alB; bf16x8 pa0, pa1;
#define RESC(a) do { if (__any((a) < 1.f)) { if (hi == 0) al_l[r32] = (a); asm volatile("s_waitcnt lgkmcnt(0)" ::: "memory");              \
                     for (int d_ = 0; d_ < 8; ++d_) for (int r = 0; r < 16; ++r) o[d_][r] *= al_l[crow(r, hi)]; } } while (0)
#define NEAR(u) ((u) * 32 + 144 > qlo)
#define SM_PART(PX, alX, u) do { if (NEAR(u)) bias_mask16(PX, qm - (u) * 32, lut); partialSM16(PX, m_reg, alX, NEAR(u) ? 0.f : bfar); } while (0)
    A2_DMA(0); A2_DMA(1);
    A2_WAITV(8); A2_BAR();
    A2_DMA(2);
    SBAR(); qkt16(pA, lds, kofs, qr);
    SM_PART(pA, alA, 0);
#define STEP(PX, alX, PY, alY, u) do {                                                                       \
        if ((u) + 1 < NS) A2_WAITV(8); else A2_WAITV(0);                                                      \
        A2_BAR();                                                                                            \
        if ((u) + 2 < NS) A2_DMA((u) + 2);                                                                   \
        SBAR(); qkt16_exp(PX, PY, (int)(uintptr_t)lds + ((u) & 3) * STG, kofs, qr);                            \
        finish_pack16(PY, alY, l_reg, pa0, pa1); SBAR();                                                     \
        pv16(o, vb0 + (((u) - 1) & 3) * STG, pa0, pa1);                                                       \
        SM_PART(PX, alX, u);                                                                                 \
        RESC(alX); } while (0)
    for (int u = 1; u + 1 < NS; u += 2) {
        STEP(pB, alB, pA, alA, u);
        STEP(pA, alA, pB, alB, u + 1);
    }
    STEP(pB, alB, pA, alA, NS - 1);
    finishSM16(pB, alB, l_reg, pa0, pa1); SBAR();
    pv16(o, vb0 + ((NS - 1) & 3) * STG, pa0, pa1);
    if (hi == 0) li_l[r32] = l_reg;
    asm volatile("s_waitcnt lgkmcnt(0)" ::: "memory");
    float rli[16];
#pragma unroll
    for (int r = 0; r < 16; ++r) rli[r] = __builtin_amdgcn_rcpf(li_l[crow(r, hi)]);
    A2_BAR();
    float* xch = (float*)(lds + rg * 32768);
    if (mp == 1) {
#pragma unroll
        for (int r = 0; r < 16; ++r) { const float f = lam * rli[r];
#pragma unroll
            for (int d0 = 0; d0 < 8; ++d0) xch[crow(r, hi) * 256 + d0 * 32 + r32] = o[d0][r] * f; }
    }
    A2_BAR();
    if (mp == 0) {
        int lane_e = lane; asm volatile("" : "+v"(lane_e)); const int r32e = lane_e & 31;
        float ssq[16];
#pragma unroll
        for (int r = 0; r < 16; ++r) { float s = 0.f;
#pragma unroll
            for (int d0 = 0; d0 < 8; ++d0) { const float v = o[d0][r] * rli[r] - xch[crow(r, hi) * 256 + d0 * 32 + r32]; o[d0][r] = v; s += v * v; }
            ssq[r] = s; }
#pragma unroll
        for (int st = 1; st < 32; st <<= 1) {
#pragma unroll
            for (int r = 0; r < 16; ++r) ssq[r] += __int_as_float(__builtin_amdgcn_ds_bpermute((lane_e ^ st) << 2, __float_as_int(ssq[r]))); }
        float g[8];
#pragma unroll
        for (int d0 = 0; d0 < 8; ++d0) g[d0] = subln[d0 * 32 + r32e] * oml;
        char* Ow = (char*)(Ob + (size_t)qlo * OLD + h * 256); const unsigned ooff = (unsigned)(4 * hi * OLD + r32e) * 2u;
#pragma unroll
        for (int r = 0; r < 16; ++r) { const float rs = __builtin_amdgcn_rsqf(ssq[r] * (1.0f / 256.0f) + 1e-6f); const int orow0 = (r & 3) + 8 * (r >> 2);
#pragma unroll
            for (int d0 = 0; d0 < 8; ++d0) { const float v = o[d0][r] * rs * g[d0]; const float vn = __int_as_float(__builtin_amdgcn_ds_bpermute((lane_e ^ 1) << 2, __float_as_int(v)));
                if ((r32 & 1) == 0) *(unsigned*)(Ow + (size_t)(orow0 * OLD + d0 * 32) * 2 + ooff) = cvtpk(v, vn); } }
    }
    A2_WAITV(0); A2_BAR();
#undef A2_DMA
#undef RESC
#undef NEAR
#undef SM_PART
#undef STEP
}
#undef SBAR
}
template <bool EXIT>
__device__ __forceinline__ void attnB_phase(Frame& F, const bf16* Q, const bf16* KV, bf16* O) {
    int tid = CUR_TID(F);
    char* lds = (char*)(F.lds + RING_OFF);
    int vc0 = F.vcu; asm volatile("" : "+s"(vc0));
    for (int vc = vc0; vc < 256; vc += F.G) {
        const int bh = vc >> 3, p = vc & 7, b = bh >> 4, h = bh & 15;
        const bf16* Qb = Q + (size_t)b * SEQ * DM + h * 128; const bf16* Kb = KV + (size_t)b * SEQ * NKV + h * 128; const bf16* Vb = Kb + DM;
        bf16* Ob = O + (size_t)b * SEQ * DM + h * 128;
        for (int i = 0; i < 4; ++i) {
            const int qb = ((i >> 1) << 4) + ((i & 1) ? 15 - p : p);
            const att::BlockRef cur{Qb + (size_t)qb * 256 * DM, Kb, Vb, Ob + (size_t)qb * 256 * DM, qb * 256};
            att::sb_block<DM, NKV, NKV, DM, EXIT>(cur, lds, tid);
        }
    }
}

__device__ __forceinline__ void attnA2_phase(Frame& F, const bf16* QKV, bf16* O, const float* rel_bias, const float* lamv, const float* subln, int layer) {
    int tid = CUR_TID(F);
    const int lane = tid & 63;
    asm volatile("" : "+s"(layer)); const float lambda_init = layer == 0 ? 0.2f : 0.35550906759096924f;
    float s01 = 0.f, s23 = 0.f;
    for (int i = lane; i < 128; i += 64) { s01 += lamv[i] * lamv[128 + i]; s23 += lamv[256 + i] * lamv[384 + i]; }
    s01 = wave_sum(s01); s23 = wave_sum(s23);
    const float lam = expf(s01) - expf(s23) + lambda_init, oml = 1.0f - lambda_init;
    int vc0 = F.vcu; asm volatile("" : "+s"(vc0));
    for (int vc = vc0; vc < 256; vc += F.G) {
        const int bh = vc >> 4, p = vc & 15, b = bh >> 3, h = bh & 7;
        __syncthreads();
        asm volatile("" : "+v"(tid));
        { LAS float* lut = (LAS float*)(F.lds + att2::LDS_LUT);
          for (int i = tid; i < 2 * 272; i += 512) { const int mpi = i >= 272 ? 1 : 0; int n = i - mpi * 272 - 64; n = n < 0 ? 0 : n; lut[i] = rel_bias[t5_bucket(n) * 16 + 2 * h + mpi] * (1.0f / att::SCALE); } }
        const float bfar = rel_bias[31 * 16 + 2 * h + (tid >> 8)] * (1.0f / att::SCALE);
        __syncthreads();
        const bf16* QKVb = QKV + (size_t)b * SEQ * NQKV; bf16* Ob = O + (size_t)b * SEQ * DM;
        for (int i = 0; i < 4; ++i) {
            const int qb = ((i >> 1) << 5) + ((i & 1) ? 31 - p : p);
            att2::diff_unit<NQKV, DM>(QKVb, Ob, h, qb * 128, F.lds, tid, lam, oml, subln, bfar);
        }
    }
}

typedef const __attribute__((address_space(4))) Args* KArgs;
#define KARG() ({ KArgs ap_ = (KArgs)__builtin_amdgcn_kernarg_segment_ptr(); asm volatile("" : "+s"(ap_)); ap_; })
#define IN(k) (KARG()->in[k])
#define WS() (KARG()->ws)
__global__ void __launch_bounds__(NWAVES * 64, 2) mk_fwd(Args args_unused) {
    extern __shared__ __attribute__((aligned(16))) unsigned char lds[];
    Frame F;
    F.lds = (LAS unsigned char*)lds;
    F.MISC = (volatile LAS unsigned*)(F.lds + MISC_OFF);
    F.wave = __builtin_amdgcn_readfirstlane((int)threadIdx.x >> 6);
    F.G = gridDim.x; { const int bx = blockIdx.x; F.vcu = (F.G % 8 == 0) ? (bx % 8) * (F.G / 8) + bx / 8 : bx; }
    F.ctl = (gu32*)(WS() + WS_CTL);
    for (int u = threadIdx.x; u < (LDS_BYTES - LDSCTL_OFF) / 4; u += NWAVES * 64) ((LAS unsigned*)(F.lds + LDSCTL_OFF))[u] = 0u;
    __syncthreads();
    (void)xcd_barrier_post((unsigned*)(F.ctl + CW_BAR), F.MISC + 8);
#define GRID_BAR() do { XcdBarrier b_; b_.bar = (unsigned*)(WS() + WS_CTL) + CW_BAR; b_.x = xb_xcc_id(); b_.st = F.MISC + 8; b_.tid = CUR_TID(F); xcd_barrier(b_); } while (0)
#define XO() (KARG()->out)
#define WSP(off) ((bf16*)(WS() + (off)))
#define XN WSP(WS_XN)
#define OB WSP(WS_OB)
#define HB WSP(WS_H)
#define QKV WSP(WS_QKV)
#define KVSH WSP(WS_KVSH)

#define SSV(v) ((float*)(WS() + WS_SS) + (size_t)(v) * M * 32)
#define RSTAB ((PG8_LAS float*)(F.lds + RSTD_OFF))
    {
        LAS float* scr = (LAS float*)(F.lds + RING_OFF + F.wave * 16384);
        transpose_group<true >(F, F.vcu, F.G, IN(2), IN(1), 4, DM, NWI, (bf16*)(WS() + WS_WI_PRE), scr);
        transpose_group<true >(F, F.vcu, F.G, IN(6), IN(5), 4, DM, NWI, (bf16*)(WS() + WS_WI_POST), scr);
        transpose_group<false>(F, F.vcu, F.G, IN(9), IN(4), 2, DM, NQKV, (bf16*)(WS() + WS_AWQKV), scr);
        transpose_group<false>(F, F.vcu, F.G, IN(16), IN(15), 1, DM, NKV, (bf16*)(WS() + WS_BWKV), scr);
        cast_rows(F, IN(0), XN, SSV(0));
    }
    GRID_BAR();

    for (int l = 0; l < 4; ++l) {
        if (l == 2) {
            pg8::Gemm g{XN, (const bf16*)(WS() + WS_BWKV), M, NKV, DM}; pg8::StaticOrder S; S.init(M, NKV, F.G, (int)blockIdx.x);
            pg8::preload_rstd(S, SSV(6), RSTAB, CUR_TID(F));
            pg8::EpiBf16 E{KVSH, NKV, RSTAB};
            pg8::gemm_phase<pg8::EpiBf16, pg8::StaticOrder, true, true>(F.lds + RING_OFF, g, S, E, CUR_TID(F));
        }
        for (int s = 0; s < 2; ++s) {
            {
                const bf16* wi = (const bf16*)(WS() + (s ? WS_WI_POST : WS_WI_PRE) + (size_t)l * SZ_WI);
                pg8::Gemm g{XN, wi, M, NWI, DM}; pg8::StaticOrder S; S.init(M, NWI, F.G, (int)blockIdx.x);
                pg8::preload_rstd(S, SSV(3 * l + 2 * s), RSTAB, CUR_TID(F));
                pg8::EpiSwiGLU E{HB, DFF, RSTAB};
                pg8::gemm_phase<pg8::EpiSwiGLU, pg8::StaticOrder, true, true>(F.lds + RING_OFF, g, S, E, CUR_TID(F));
            }
            {
                const int rem_ = ((M / 256) * (NWI / 256)) % F.G, c_ = (int)blockIdx.x;
                if (rem_ == 0 || c_ >= rem_) {
                    const int part_ = rem_ ? c_ - rem_ : F.vcu, nparts_ = rem_ ? F.G - rem_ : F.G;
                    LAS float* scr = (LAS float*)(F.lds + RING_OFF + F.wave * 16384);
                    transpose_group<false>(F, part_, nparts_, (s ? IN(7) : IN(3)) + (size_t)l * DFF * DM, nullptr, 1, DFF, DM, (bf16*)(WS() + (s ? WS_WO_POST : WS_WO_PRE) + (size_t)l * SZ_WO), scr);
                    const float* xw = nullptr; const float* xg = nullptr; bf16* xd = nullptr; float xs = 1.0f;
                    if (s == 0) { if (l < 2) { xw = IN(14) + (size_t)l * DM * DM; xd = (bf16*)(WS() + WS_AWO + (size_t)l * SZ_DD); } else { xw = IN(18) + (size_t)(l - 2) * DM * DM; xd = (bf16*)(WS() + WS_BWO + (size_t)(l - 2) * SZ_DD); } }
                    else if (l == 1 || l == 2) { xw = IN(17) + (size_t)(l - 1) * DM * DM; xg = IN(4) + (size_t)(l + 1) * DM; xd = (bf16*)(WS() + WS_BWQ + (size_t)(l - 1) * SZ_DD); xs = att::SCALE * 1.4426950408889634f; }
                    if (xw) transpose_group<false>(F, part_, nparts_, xw, xg, 1, DM, DM, xd, scr, xs);
                }
            }
            GRID_BAR();
            {
                const bf16* wo = (const bf16*)(WS() + (s ? WS_WO_POST : WS_WO_PRE) + (size_t)l * SZ_WO);
                pg8::Gemm g{HB, wo, M, DM, DFF}; pg8::StaticOrder S; S.init(M, DM, F.G, (int)blockIdx.x);
                if (l == 3 && s == 1) {
                    pg8::EpiResid16<true> E{XN, nullptr, XO(), DM, 0.5f};
                    pg8::gemm_phase<pg8::EpiResid16<true>, pg8::StaticOrder, true, true>(F.lds + RING_OFF, g, S, E, CUR_TID(F));
                } else {
                    pg8::EpiResid16<false> E{XN, SSV(3 * l + 2 * s + 1), nullptr, DM, 0.5f};
                    pg8::gemm_phase<pg8::EpiResid16<false>, pg8::StaticOrder, false, true>(F.lds + RING_OFF, g, S, E, CUR_TID(F));
                }
            }
            GRID_BAR();
            if (s == 0) {
                if (l < 2) {
                    { LAS float* gl = (LAS float*)(F.lds + QKG_OFF); const int t_ = CUR_TID(F);
                      if (t_ < 256) gl[t_] = (t_ < 128 ? IN(10) + (size_t)l * HD : IN(11) + (size_t)l * HD - 128)[t_]; }
                    pg8::Gemm g{XN, (const bf16*)(WS() + WS_AWQKV + (size_t)l * SZ_AWQKV), M, NQKV, DM}; pg8::StaticOrder S; S.init(M, NQKV, F.G, (int)blockIdx.x);
                    pg8::preload_rstd(S, SSV(3 * l + 1), RSTAB, CUR_TID(F));
                    pg8::EpiQKV E{QKV, NQKV, (PG8_LAS float*)(F.lds + QKX_OFF), (const PG8_LAS float*)(F.lds + QKG_OFF), RSTAB};
                    pg8::gemm_phase<pg8::EpiQKV, pg8::StaticOrder, true, true>(F.lds + RING_OFF, g, S, E, CUR_TID(F));
                } else {
                    pg8::Gemm g{XN, (const bf16*)(WS() + WS_BWQ + (size_t)(l - 2) * SZ_DD), M, DM, DM}; pg8::StaticOrder S; S.init(M, DM, F.G, (int)blockIdx.x);
                    pg8::preload_rstd(S, SSV(3 * l + 1), RSTAB, CUR_TID(F));
                    pg8::EpiBf16 E{QKV, DM, RSTAB};
                    pg8::gemm_phase<pg8::EpiBf16, pg8::StaticOrder, true, true>(F.lds + RING_OFF, g, S, E, CUR_TID(F));
                }
                GRID_BAR();
                if (l < 2) {
                    attnA2_phase(F, QKV, OB, IN(8), IN(12) + (size_t)l * 512, IN(13) + (size_t)l * 256, l);
                } else {
                    attnB_phase<true>(F, QKV, KVSH, OB);
                }
                GRID_BAR();
                {
                    const bf16* w = (l < 2) ? (const bf16*)(WS() + WS_AWO + (size_t)l * SZ_DD) : (const bf16*)(WS() + WS_BWO + (size_t)(l - 2) * SZ_DD);
                    pg8::Gemm g{OB, w, M, DM, DM}; pg8::StaticOrder S; S.init(M, DM, F.G, (int)blockIdx.x);
                    pg8::EpiResid16<false> E{XN, SSV(3 * l + 2), nullptr, DM, 1.0f};
                    pg8::gemm_phase<pg8::EpiResid16<false>, pg8::StaticOrder, false, true>(F.lds + RING_OFF, g, S, E, CUR_TID(F));
                }
                GRID_BAR();
            }
        }
    }
#undef SSV
#undef RSTAB
#undef GRID_BAR
#undef XN
#undef OB
#undef HB
#undef QKV
#undef KVSH
}

extern "C" void kernel_launch(void* const* d_in, const int* in_sizes, int n_in, void* d_out, int out_size, void* d_ws, size_t ws_size, hipStream_t stream) {
    static int grid = 0;
    if (grid == 0) {
        if (n_in != 19 || in_sizes[0] != M * DM || out_size != M * DM || ws_size < WS_END) { fprintf(stderr, "kernel_launch: shape/workspace mismatch: n_in %d in0 %d out %d ws %zu (need %zu); nothing launched\n", n_in, n_in > 0 ? in_sizes[0] : -1, out_size, ws_size, (size_t)WS_END); grid = -1; return; }
        int dev = 0, cus = 0, per_cu = 0;
        if (hipGetDevice(&dev) != hipSuccess || hipDeviceGetAttribute(&cus, hipDeviceAttributeMultiprocessorCount, dev) != hipSuccess) { fprintf(stderr, "kernel_launch: device query failed\n"); grid = -1; return; }
        if (hipFuncSetAttribute((const void*)mk_fwd, hipFuncAttributeMaxDynamicSharedMemorySize, LDS_BYTES) != hipSuccess) { fprintf(stderr, "kernel_launch: hipFuncSetAttribute failed\n"); grid = -1; return; }
        if (hipOccupancyMaxActiveBlocksPerMultiprocessor(&per_cu, (const void*)mk_fwd, NWAVES * 64, LDS_BYTES) != hipSuccess || per_cu < 1)
            fprintf(stderr, "kernel_launch: note: occupancy query reports %d workgroups per CU\n", per_cu);
        (void)hipGetLastError();
        grid = cus;
    }
    if (grid < 0) return;
    if (hipMemsetD32Async((hipDeviceptr_t)((char*)d_ws + WS_CTL + (size_t)CW_BAR * 4), 0, XCD_BAR_WORDS, stream) != hipSuccess) { fprintf(stderr, "kernel_launch: memset failed\n"); return; }
    Args a{};
    for (int i = 0; i < 19; ++i) a.in[i] = (const float*)d_in[i];
    a.out = (float*)d_out; a.ws = (unsigned char*)d_ws;
    hipLaunchKernelGGL(mk_fwd, dim3(grid), dim3(NWAVES * 64), LDS_BYTES, stream, a);
    const hipError_t le = hipPeekAtLastError();
    if (le != hipSuccess) fprintf(stderr, "kernel_launch: launch failed: %s\n", hipGetErrorName(le));
}
```
